# Optimizing an MI355X kernel written in HIP

```python
import jax
import jax.numpy as jnp
from jax import lax
import numpy as np


D_MODEL = 1024
BATCH = 2
SEQ = 8192
DEPTH = 4

HEAD_DIM = 64
RET_HEADS = 4
DSA_HEADS = 4
DIL_HEADS = 8
RET_W = RET_HEADS * HEAD_DIM
DSA_W = DSA_HEADS * HEAD_DIM
DIL_W = DIL_HEADS * HEAD_DIM
D_MIX = RET_W + DSA_W + DIL_W
RET_CHUNK = 128
RET_ROPE_BASE = 10000.0
KV_LATENT = 128
IDX_HEADS = 8
IDX_DIM = 64
TOPK_MAX = 256
QUERY_BLOCK = 128
DIL_PATTERNS = ((128, 1), (512, 4), (2048, 16))
D_FF = 4 * D_MODEL
NORM_EPS = 1e-6
RET_COLS = 4 * RET_W
DSA_SIZES = (DSA_W, KV_LATENT, IDX_HEADS * IDX_DIM, IDX_DIM, IDX_HEADS)
DSA_COLS = sum(DSA_SIZES)
DIL_COLS = 3 * DIL_W
N_IN = RET_COLS + DSA_COLS + DIL_COLS

kernel_name = 'hymba_style_retention_dsa_dilated_hybrid'


def _offsets(sizes):
    return [int(o) for o in np.cumsum(sizes)[:-1]]


def rms_norm(x, w):
    xf = x.astype(jnp.float32)
    y = xf * lax.rsqrt(jnp.mean(xf * xf, axis=-1, keepdims=True) + NORM_EPS)
    return (y * w.astype(jnp.float32)).astype(x.dtype)


def rotary(x, pos):
    half = x.shape[-1] // 2
    inv = RET_ROPE_BASE ** (-jnp.arange(half, dtype=jnp.float32) / half)
    ang = pos.astype(jnp.float32)[:, None] * inv[None, :]
    cos = jnp.cos(ang)[None, :, None, :]
    sin = jnp.sin(ang)[None, :, None, :]
    xf = x.astype(jnp.float32)
    x1, x2 = xf[..., :half], xf[..., half:]
    return jnp.concatenate([x1 * cos - x2 * sin, x2 * cos + x1 * sin], axis=-1)


def retention_chunkwise(q, k, v):
    B, S, H, d = q.shape
    C = RET_CHUNK
    N = S // C
    log_g = jnp.log(1.0 - 2.0 ** (-5.0 - jnp.arange(H, dtype=jnp.float32)))

    def chunks(t):
        return t.reshape(B, N, C, H, d).transpose(0, 3, 1, 2, 4)

    qc, kc, vc = chunks(q), chunks(k * (d ** -0.5)), chunks(v)
    i = jnp.arange(C, dtype=jnp.float32)
    diff = i[:, None] - i[None, :]
    decay = jnp.exp(jnp.maximum(diff, 0.0)[None] * log_g[:, None, None]) * (diff >= 0)[None]
    inner = jnp.einsum('bhncd,bhnmd->bhncm', qc, kc) * decay[None, :, None]
    inner = jnp.einsum('bhncm,bhnme->bhnce', inner, vc)
    zeta = jnp.exp((C - 1.0 - i)[None, :] * log_g[:, None])
    xi = jnp.exp((i + 1.0)[None, :] * log_g[:, None])
    kv = jnp.einsum('bhnmd,bhnme->nbhde', kc * zeta[None, :, None, :, None], vc)
    g_chunk = jnp.exp(C * log_g)[None, :, None, None]

    def step(state, kv_n):
        return g_chunk * state + kv_n, state

    _, state_prev = lax.scan(step, jnp.zeros((B, H, d, d), jnp.float32), kv)
    cross = jnp.einsum('bhncd,nbhde->bhnce', qc, state_prev) * xi[None, :, None, :, None]
    o = inner + cross
    return o.transpose(0, 2, 3, 1, 4).reshape(B, S, H, d)


def retention_mixer(cols, norm_w, pos):
    B, S, _ = cols.shape
    q, k, v, g = jnp.split(cols, 4, axis=-1)
    shp = (B, S, RET_HEADS, HEAD_DIM)
    o = retention_chunkwise(rotary(q.reshape(shp), pos), rotary(k.reshape(shp), pos),
                            v.reshape(shp).astype(jnp.float32))
    mu = jnp.mean(o, axis=-1, keepdims=True)
    var = jnp.mean(jnp.square(o - mu), axis=-1, keepdims=True)
    o = (o - mu) * lax.rsqrt(var + NORM_EPS) * norm_w.astype(jnp.float32)
    o = o.reshape(B, S, RET_W)
    return (jax.nn.silu(g.astype(jnp.float32)) * o).astype(cols.dtype)


def dsa_mixer(cols, kv_norm_w, w_uk, w_uv):
    B, S, _ = cols.shape
    q, c_kv, q_idx, k_idx, w_idx = jnp.split(cols, _offsets(DSA_SIZES), axis=-1)
    q = q.reshape(B, S, DSA_HEADS, HEAD_DIM)
    c_kv = rms_norm(c_kv, kv_norm_w)
    k = (c_kv @ w_uk).reshape(B, S, DSA_HEADS, HEAD_DIM)
    v = (c_kv @ w_uv).reshape(B, S, DSA_HEADS, HEAD_DIM)
    q_idx = q_idx.reshape(B, S, IDX_HEADS, IDX_DIM)
    w_idx = w_idx * (IDX_HEADS ** -0.5 * IDX_DIM ** -0.5)
    n_sel = min(TOPK_MAX, S // 4)
    nblk = S // QUERY_BLOCK
    key_pos = jnp.arange(S)

    def to_blocks(t):
        return jnp.moveaxis(t.reshape((B, nblk, QUERY_BLOCK) + t.shape[2:]), 1, 0)

    def block(args):
        qb, qib, wb, start = args
        qpos = start + jnp.arange(QUERY_BLOCK)
        logits = jnp.einsum('bqhd,bsd->bqhs', qib, k_idx)
        score = jnp.einsum('bqhs,bqh->bqs', jax.nn.relu(logits), wb).astype(jnp.float32)
        causal = key_pos[None, :] <= qpos[:, None]
        score = jnp.where(causal[None], score, -jnp.inf)
        _, idx = lax.top_k(score, n_sel)
        k_sel = jax.vmap(lambda kb, ib: kb[ib])(k, idx)
        v_sel = jax.vmap(lambda vb, ib: vb[ib])(v, idx)
        s = jnp.einsum('bqhd,bqnhd->bhqn', qb, k_sel).astype(jnp.float32) * (HEAD_DIM ** -0.5)
        valid = (idx <= qpos[None, :, None])[:, None]
        p = jax.nn.softmax(jnp.where(valid, s, -jnp.inf), axis=-1).astype(v.dtype)
        return jnp.einsum('bhqn,bqnhd->bqhd', p, v_sel)

    starts = jnp.arange(nblk) * QUERY_BLOCK
    o = lax.map(block, (to_blocks(q), to_blocks(q_idx), to_blocks(w_idx), starts))
    return jnp.moveaxis(o, 0, 1).reshape(B, S, DSA_W).astype(cols.dtype)


def dilated_branch(q, k, v, window, dilation):
    B, S, H, d = q.shape
    steps = window // dilation
    n = S // dilation
    lb = min(steps, n)
    nb = -(-n // lb)
    pad = nb * lb - n

    def to_sub(t):
        t = t.reshape(B, n, dilation, H, d).transpose(0, 2, 3, 1, 4)
        t = jnp.pad(t, ((0, 0), (0, 0), (0, 0), (0, pad), (0, 0)))
        return t.reshape(B, dilation, H, nb, lb, d)

    def with_prev(t):
        prev = jnp.pad(t, ((0, 0), (0, 0), (0, 0), (1, 0), (0, 0), (0, 0)))[:, :, :, :-1]
        return jnp.concatenate([prev, t], axis=4)

    qs = to_sub(q)
    kk = with_prev(to_sub(k))
    vv = with_prev(to_sub(v)).astype(jnp.float32)
    qi = jnp.arange(lb)[:, None]
    kj = jnp.arange(2 * lb)[None, :]
    dist = lb + qi - kj
    key_idx = jnp.arange(nb)[:, None, None] * lb - lb + kj[None]
    mask = (dist >= 0) & (dist <= steps) & (key_idx >= 0)
    s = jnp.einsum('brhnqd,brhnkd->brhnqk', qs, kk).astype(jnp.float32) * (d ** -0.5)
    s = jnp.where(mask, s, -jnp.inf)
    m = jnp.max(s, axis=-1, keepdims=True)
    p = jnp.exp(s - m)
    den = jnp.sum(p, axis=-1, keepdims=True)
    o = jnp.einsum('brhnqk,brhnkd->brhnqd', p, vv) / den
    lse = (m + jnp.log(den))[..., 0]
    o = o.reshape(B, dilation, H, nb * lb, d)[:, :, :, :n].transpose(0, 3, 1, 2, 4).reshape(B, S, H, d)
    lse = lse.reshape(B, dilation, H, nb * lb)[:, :, :, :n].transpose(0, 3, 1, 2).reshape(B, S, H)
    return o, lse


def dilated_mixer(cols):
    B, S, _ = cols.shape
    q, k, v = jnp.split(cols, 3, axis=-1)
    shp = (B, S, DIL_HEADS, HEAD_DIM)
    q, k, v = q.reshape(shp), k.reshape(shp), v.reshape(shp)
    outs = []
    lses = []
    for window, dilation in DIL_PATTERNS:
        o, lse = dilated_branch(q, k, v, window, dilation)
        outs.append(o)
        lses.append(lse)
    alpha = jax.nn.softmax(jnp.stack(lses, axis=0), axis=0)
    o = jnp.sum(alpha[..., None] * jnp.stack(outs, axis=0), axis=0)
    return o.reshape(B, S, DIL_W).astype(cols.dtype)


def hybrid_layer(x, attn_norm_w, w_in, ret_norm_w, kv_norm_w, w_uk, w_uv, w_out, mlp_norm_w, w_up, w_down, pos):
    h = rms_norm(x, attn_norm_w)
    proj = h @ w_in
    ret_cols, dsa_cols, dil_cols = jnp.split(proj, _offsets((RET_COLS, DSA_COLS, DIL_COLS)), axis=-1)
    mixed = jnp.concatenate([retention_mixer(ret_cols, ret_norm_w, pos),
                             dsa_mixer(dsa_cols, kv_norm_w, w_uk, w_uv),
                             dilated_mixer(dil_cols)], axis=-1)
    x = x + mixed @ w_out
    h = rms_norm(x, mlp_norm_w)
    return x + jnp.square(jax.nn.relu(h @ w_up)) @ w_down


def setup_inputs(seed: int = 0) -> dict:
    key = jax.random.key(seed)
    ks = jax.random.split(key, 12)
    f32 = jnp.float32

    def nrm(k, shape, scale):
        return jax.random.normal(k, shape, f32) * scale

    return {
        'x': nrm(ks[0], (BATCH, SEQ, D_MODEL), 1.0),
        'attn_norm_w': 1.0 + nrm(ks[1], (DEPTH, D_MODEL), 0.02),
        'w_in': nrm(ks[2], (DEPTH, D_MODEL, N_IN), D_MODEL ** -0.5),
        'ret_norm_w': 1.0 + nrm(ks[3], (DEPTH, RET_HEADS, HEAD_DIM), 0.02),
        'dsa_kv_norm_w': 1.0 + nrm(ks[4], (DEPTH, KV_LATENT), 0.02),
        'dsa_w_uk': nrm(ks[5], (DEPTH, KV_LATENT, DSA_W), KV_LATENT ** -0.5),
        'dsa_w_uv': nrm(ks[6], (DEPTH, KV_LATENT, DSA_W), KV_LATENT ** -0.5),
        'w_out': nrm(ks[7], (DEPTH, D_MIX, D_MODEL), D_MIX ** -0.5),
        'mlp_norm_w': 1.0 + nrm(ks[8], (DEPTH, D_MODEL), 0.02),
        'w_up': nrm(ks[9], (DEPTH, D_MODEL, D_FF), D_MODEL ** -0.5),
        'w_down': nrm(ks[10], (DEPTH, D_FF, D_MODEL), D_FF ** -0.5),
        'final_norm_w': 1.0 + nrm(ks[11], (D_MODEL,), 0.02),
    }


def reference(x, attn_norm_w, w_in, ret_norm_w, dsa_kv_norm_w, dsa_w_uk, dsa_w_uv, w_out, mlp_norm_w, w_up, w_down, final_norm_w):
    pos = jnp.arange(x.shape[1])
    for layer in range(DEPTH):
        x = hybrid_layer(x, attn_norm_w[layer], w_in[layer], ret_norm_w[layer], dsa_kv_norm_w[layer],
                         dsa_w_uk[layer], dsa_w_uv[layer], w_out[layer], mlp_norm_w[layer],
                         w_up[layer], w_down[layer], pos)
    return rms_norm(x, final_norm_w)
```

```cpp
#include <hip/hip_runtime.h>
#include <hip/hip_cooperative_groups.h>
#include <cstdio>
#include <cstdint>
namespace cg = cooperative_groups;
namespace pg8 {
#define PG8_LAS __attribute__((address_space(3)))
typedef unsigned short bf16_t;
typedef short bf16x8 __attribute__((ext_vector_type(8)));
typedef float f32x4 __attribute__((ext_vector_type(4)));
typedef unsigned u32x4 __attribute__((ext_vector_type(4)));
constexpr int BM = 256, BK = 64, HALF = 128, HTB = HALF * BK * 2  , STAGE_BYTES = 8 * HTB, NXCD = 8, WGM = 8;

__host__ __device__ __forceinline__ int lds_byte(int r, int c) { const int st = (r >> 4) * 2 + (c >> 5), rr = r & 15, cc = c & 31, ob = rr * 64 + cc * 2; return st * 1024 + (ob ^ (((ob >> 9) & 1) << 5)); }
__host__ __device__ __forceinline__ void stage_rc(int b, int& R, int& C) { const int st = b / 1024, sb = b % 1024, swz = sb ^ (((sb >> 9) & 1) << 5); R = (st >> 1) * 16 + swz / 64; C = (st & 1) * 32 + (swz % 64) / 2; }
__host__ __device__ __forceinline__ int perm32(int rho) { const int n = rho >> 4, i = rho & 15; return 8 * (i >> 2) + 4 * n + (i & 3); }

struct Unit { int pm, pn; };
struct Gemm { const bf16_t* A; const bf16_t* Bt; int M, N, K; };

struct StaticOrder {
    int nM, nN, nwg, G, c;
    __host__ __device__ void init(int M, int N, int G_, int c_) { nM = M / BM; nN = N / BM; nwg = nM * nN; G = G_; c = c_; }
    __host__ __device__ bool next(int i, Unit& u) const {
        const long L = (long)i * G + c; if (L >= nwg) return false;
        int wgid = (int)L; { const int q = nwg / NXCD, r = nwg % NXCD, xcd = wgid % NXCD, off = wgid / NXCD; wgid = (xcd < r ? xcd * (q + 1) : r * (q + 1) + (xcd - r) * q) + off; }
        const int nig = WGM * nN, gid = wgid / nig, fm = gid * WGM, gsz = (nM - fm) < WGM ? (nM - fm) : WGM;
        u.pm = fm + ((wgid % nig) % gsz); u.pn = (wgid % nig) / gsz; return true;
    }
    __device__ __forceinline__ void a_ready(const Unit&) const {}
    __device__ __forceinline__ void done(const Unit&) const {}
};
__device__ __forceinline__ unsigned cvt_pk_bf16(float lo, float hi) { unsigned r; asm volatile("v_cvt_pk_bf16_f32 %0, %1, %2" : "=v"(r) : "v"(lo), "v"(hi)); return r; }
typedef float f32x2 __attribute__((ext_vector_type(2)));
typedef unsigned u32x2 __attribute__((ext_vector_type(2)));
template <int ACT> struct EpiBf16 {
    static constexpr bool PERM = true, AFTER_DRAIN = false;
    bf16_t* O; int ldc; int slot_rows; int frag_slot; int perm_lo; const float* ssq;
    __device__ __forceinline__ void operator()(const f32x4 (&acc)[2][2][4][2], const Unit& u, int wr, int wc, int fr, int fq) const {
        const int row0 = u.pm * BM + wr * 64 + fr + (slot_rows ? (u.pn * 4 + (wc >> 1)) * slot_rows : 0); const int col0 = (slot_rows ? (wc & 1) * 32 : u.pn * BM + wc * 32) + 8 * fq;
        unsigned sraw[2][4];
#pragma unroll
        for (int ai = 0; ai < 2; ++ai)
#pragma unroll
            for (int m = 0; m < 4; ++m) sraw[ai][m] = __hip_atomic_load((const unsigned*)ssq + (u.pm * BM + wr * 64 + fr + ai * HALF + m * 16), __ATOMIC_RELAXED, __HIP_MEMORY_SCOPE_AGENT);
#pragma unroll
        for (int ai = 0; ai < 2; ++ai)
#pragma unroll
            for (int m = 0; m < 4; ++m) { bf16_t* rowp = O + (size_t)(row0 + ai * HALF + m * 16) * ldc + col0;
                const float rs = rsqrtf((float)sraw[ai][m] * (1.f / (1024.f * 1024.f)) + 1e-6f);
#pragma unroll
                for (int bj = 0; bj < 2; ++bj) { f32x4 v0 = acc[ai][bj][m][0] * rs, v1 = acc[ai][bj][m][1] * rs;
                    if (ACT == 2) {
#pragma unroll
                        for (int e = 0; e < 4; ++e) { const float a = fmaxf(v0[e], 0.f), b = fmaxf(v1[e], 0.f); v0[e] = a * a; v1[e] = b * b; } }
                    u32x4 w; w.x = cvt_pk_bf16(v0[0], v0[1]); w.y = cvt_pk_bf16(v0[2], v0[3]); w.z = cvt_pk_bf16(v1[0], v1[1]); w.w = cvt_pk_bf16(v1[2], v1[3]);
                    bf16_t* dst = rowp + (slot_rows ? (size_t)bj * 2 * slot_rows * 64 : (size_t)(bj * HALF));
                    const int slot = u.pn * 4 + (wc >> 1) + 2 * bj;
                    if (slot_rows && (slot == frag_slot || slot >= perm_lo)) { int tok = u.pm * BM + wr * 64 + fr + ai * HALF + m * 16; const int c0 = (wc & 1) * 32 + 8 * fq;
                        if (slot >= perm_lo) tok = (tok & ~8191) + (tok & 15) * 512 + ((tok & 8191) >> 4);
                        dst = O + (size_t)slot * slot_rows * 64 + (size_t)(tok >> 5) * 2048 + ((((c0 >> 4) * 2 + ((c0 >> 3) & 1)) * 32 + (tok & 31)) * 8); }
                    *(u32x4*)dst = w; } }
    }
};
struct EpiResidB {
    static constexpr bool PERM = true, AFTER_DRAIN = false;
    bf16_t* xb; int ldc; float* ssq;
    __device__ __forceinline__ void operator()(const f32x4 (&acc)[2][2][4][2], const Unit& u, int wr, int wc, int fr, int fq) const {
        const int col0 = u.pn * BM + wc * 32 + 8 * fq;
#pragma unroll
        for (int ai = 0; ai < 2; ++ai) {
            u32x4 bs[4][2];
#pragma unroll
            for (int m = 0; m < 4; ++m)
#pragma unroll
                for (int bj = 0; bj < 2; ++bj) bs[m][bj] = *(const u32x4*)(xb + (size_t)(u.pm * BM + ai * HALF + wr * 64 + m * 16 + fr) * ldc + col0 + bj * HALF);
            asm volatile("" ::: "memory");
#pragma unroll
            for (int m = 0; m < 4; ++m) { bf16_t* rowp = xb + (size_t)(u.pm * BM + ai * HALF + wr * 64 + m * 16 + fr) * ldc + col0;
                float sq = 0.f;
#pragma unroll
                for (int bj = 0; bj < 2; ++bj) { const u32x4 b = bs[m][bj]; f32x4 v0 = acc[ai][bj][m][0], v1 = acc[ai][bj][m][1];
                    v0[0] += __uint_as_float(b.x << 16); v0[1] += __uint_as_float(b.x & 0xffff0000u); v0[2] += __uint_as_float(b.y << 16); v0[3] += __uint_as_float(b.y & 0xffff0000u);
                    v1[0] += __uint_as_float(b.z << 16); v1[1] += __uint_as_float(b.z & 0xffff0000u); v1[2] += __uint_as_float(b.w << 16); v1[3] += __uint_as_float(b.w & 0xffff0000u);
                    sq += ((v0[0] * v0[0] + v0[1] * v0[1]) + (v0[2] * v0[2] + v0[3] * v0[3])) + ((v1[0] * v1[0] + v1[1] * v1[1]) + (v1[2] * v1[2] + v1[3] * v1[3]));
                    u32x4 w; w.x = cvt_pk_bf16(v0[0], v0[1]); w.y = cvt_pk_bf16(v0[2], v0[3]); w.z = cvt_pk_bf16(v1[0], v1[1]); w.w = cvt_pk_bf16(v1[2], v1[3]);
                    *(u32x4*)(rowp + bj * HALF) = w; }
                { auto r16 = __builtin_amdgcn_permlane16_swap(__float_as_uint(sq), __float_as_uint(sq), false, false); sq = __uint_as_float(r16[0]) + __uint_as_float(r16[1]);
                  auto r32 = __builtin_amdgcn_permlane32_swap(__float_as_uint(sq), __float_as_uint(sq), false, false); sq = __uint_as_float(r32[0]) + __uint_as_float(r32[1]); }
                if (fq == 0) __hip_atomic_fetch_add((unsigned*)ssq + (u.pm * BM + ai * HALF + wr * 64 + m * 16 + fr), (unsigned)(sq * 1024.f + 0.5f), __ATOMIC_RELAXED, __HIP_MEMORY_SCOPE_AGENT); }
            asm volatile("" ::: "memory");
        }
    }
};

template <class Epi, class Sched, bool ALIGN_EPI = false, bool SP2 = false>
__device__ __forceinline__ void gemm_phase(PG8_LAS unsigned char* lds, const Gemm g, const Sched& S, const Epi& E) {
    int tid_l = threadIdx.x; asm volatile("" : "+v"(tid_l));
    const int tid = tid_l, wid = __builtin_amdgcn_readfirstlane(tid >> 6), lane = tid & 63, wr = wid >> 2, wc = wid & 3, fr = lane & 15, fq = lane >> 4;
    const int K = g.K, nt = K / BK;
    unsigned voffA[2], voffB[2];
#pragma unroll
    for (int i = 0; i < 2; ++i) { int R, C; stage_rc(tid * 16 + i * 8192, R, C); const int Rb = Epi::PERM ? ((R & ~31) + perm32(R & 31)) : R;
        voffA[i] = (unsigned)(R * K + C) * 2u; voffB[i] = (unsigned)(Rb * K + C) * 2u; }
    const size_t kstep = (size_t)(BK * 2);
    const size_t hstep = (size_t)HALF * K * 2;
    const size_t tstep = 2 * hstep;
    const unsigned ldsw = (unsigned)wid * 1024u;
    const int aoff = lds_byte(wr * 64 + fr, fq * 8), boff = lds_byte(wc * 32 + fr, fq * 8);
#define PG8_SA(b, h) (((b) * 2 + (h)) * HTB)
#define PG8_SB(b, h) ((4 + (b) * 2 + (h)) * HTB)
#define PG8_STAGE(bufoff, gbase, voff) do { _Pragma("unroll") for (int _i = 0; _i < 2; ++_i) \
        __builtin_amdgcn_global_load_lds((const unsigned*)((const char*)(gbase) + (voff)[_i]), (PG8_LAS unsigned*)(lds + (bufoff) + ldsw + _i * 8192), 16, 0, 0); } while (0)
#define PG8_LDA(dst, b, h) do { _Pragma("unroll") for (int m = 0; m < 4; ++m) _Pragma("unroll") for (int k = 0; k < 2; ++k) dst[m][k] = *(const PG8_LAS bf16x8*)(lds + PG8_SA(b, h) + aoff + m * 2048 + k * 1024); } while (0)
#define PG8_LDB(dst, b, h) do { _Pragma("unroll") for (int n = 0; n < 2; ++n) _Pragma("unroll") for (int k = 0; k < 2; ++k) dst[n][k] = *(const PG8_LAS bf16x8*)(lds + PG8_SB(b, h) + boff + n * 2048 + k * 1024); } while (0)
#define PG8_MMA(ai, bj, At, Bt) do { __builtin_amdgcn_s_setprio(1); _Pragma("unroll") for (int m = 0; m < 4; ++m) _Pragma("unroll") for (int n = 0; n < 2; ++n) _Pragma("unroll") for (int k = 0; k < 2; ++k) \
        acc[ai][bj][m][n] = __builtin_amdgcn_mfma_f32_16x16x32_bf16(Bt[n][k], At[m][k], acc[ai][bj][m][n], 0, 0, 0); __builtin_amdgcn_s_setprio(0); } while (0)
#define PG8_WAIT_V(n) asm volatile("s_waitcnt vmcnt(" #n ")" ::: "memory")
#define PG8_WAIT_L(n) asm volatile("s_waitcnt lgkmcnt(" #n ")" ::: "memory")
#define PG8_BAR __builtin_amdgcn_s_barrier()
#define PG8_SCHED __builtin_amdgcn_sched_barrier(0)
    Unit cur, nxt; int ui = 0;
    if (!S.next(0, cur)) return;
    f32x4 acc[2][2][4][2];
#pragma unroll
    for (int a = 0; a < 2; ++a)
#pragma unroll
        for (int b = 0; b < 2; ++b)
#pragma unroll
            for (int m = 0; m < 4; ++m)
#pragma unroll
                for (int n = 0; n < 2; ++n) acc[a][b][m][n] = (f32x4){0.f, 0.f, 0.f, 0.f};
    bf16x8 At[4][2], B0[2][2], B1[2][2];
    const char* cA = (const char*)g.A + (size_t)cur.pm * tstep; const char* cB = (const char*)g.Bt + (size_t)cur.pn * tstep;
    S.a_ready(cur);
    if constexpr (SP2) {
        PG8_STAGE(PG8_SB(0, 0), cB, voffB); PG8_STAGE(PG8_SB(0, 1), cB + hstep, voffB); PG8_STAGE(PG8_SA(0, 0), cA, voffA); PG8_STAGE(PG8_SA(0, 1), cA + hstep, voffA);
        if (wr == 1) PG8_BAR;
        PG8_WAIT_V(2); PG8_BAR;
        PG8_STAGE(PG8_SB(1, 0), cB + kstep, voffB); PG8_STAGE(PG8_SA(1, 0), cA + kstep, voffA); PG8_STAGE(PG8_SB(1, 1), cB + hstep + kstep, voffB);
        PG8_WAIT_V(6); PG8_BAR;
    } else {
        PG8_STAGE(PG8_SB(0, 0), cB, voffB); PG8_STAGE(PG8_SA(0, 0), cA, voffA); PG8_STAGE(PG8_SB(0, 1), cB + hstep, voffB); PG8_STAGE(PG8_SA(0, 1), cA + hstep, voffA);
        if (wr == 1) PG8_BAR;
        PG8_WAIT_V(4); PG8_BAR;
        PG8_STAGE(PG8_SB(1, 0), cB + kstep, voffB); PG8_STAGE(PG8_SA(1, 0), cA + kstep, voffA); PG8_STAGE(PG8_SB(1, 1), cB + hstep + kstep, voffB);
        PG8_WAIT_V(6); PG8_BAR;
    }
    for (;;) {
        const bool has_next = S.next(ui + 1, nxt);
        const char* nA = has_next ? (const char*)g.A + (size_t)nxt.pm * tstep : cA; const char* nB = has_next ? (const char*)g.Bt + (size_t)nxt.pn * tstep : cB;
        for (int t = 0; t < nt; t += 2) {
            const bool last = (t == nt - 2);
            const char* a1 = cA + (size_t)(t + 1) * kstep;
            const char* a2 = last ? nA : cA + (size_t)(t + 2) * kstep; const char* b2 = last ? nB : cB + (size_t)(t + 2) * kstep;
            const char* a3 = a2 + kstep; const char* b3 = b2 + kstep;
            if (last && has_next) S.a_ready(nxt);
            if constexpr (SP2) {
            PG8_LDB(B0, 0, 0); PG8_LDB(B1, 0, 1); PG8_SCHED; PG8_LDA(At, 0, 0); PG8_STAGE(PG8_SA(1, 1), a1 + hstep, voffA);
            PG8_WAIT_V(8); PG8_WAIT_L(0); PG8_BAR; PG8_MMA(0, 0, At, B0); PG8_MMA(0, 1, At, B1); PG8_BAR; PG8_SCHED;
            PG8_LDA(At, 0, 1); PG8_STAGE(PG8_SB(0, 0), b2, voffB); PG8_STAGE(PG8_SB(0, 1), b2 + hstep, voffB); PG8_STAGE(PG8_SA(0, 0), a2, voffA);
            PG8_WAIT_V(8); PG8_WAIT_L(0); PG8_BAR; PG8_MMA(1, 0, At, B0); PG8_MMA(1, 1, At, B1); PG8_BAR; PG8_SCHED;
            PG8_LDB(B0, 1, 0); PG8_LDB(B1, 1, 1); PG8_SCHED; PG8_LDA(At, 1, 0); PG8_STAGE(PG8_SA(0, 1), a2 + hstep, voffA);
            PG8_WAIT_V(8); PG8_WAIT_L(0); PG8_BAR; PG8_MMA(0, 0, At, B0); PG8_MMA(0, 1, At, B1); PG8_BAR; PG8_SCHED;
            PG8_LDA(At, 1, 1); PG8_STAGE(PG8_SB(1, 0), b3, voffB); PG8_STAGE(PG8_SB(1, 1), b3 + hstep, voffB); PG8_STAGE(PG8_SA(1, 0), a3, voffA);
            PG8_WAIT_V(8); PG8_WAIT_L(0); PG8_BAR; PG8_MMA(1, 0, At, B0); PG8_MMA(1, 1, At, B1); PG8_BAR; PG8_SCHED;
            } else {
            PG8_LDB(B0, 0, 0); PG8_SCHED; PG8_LDA(At, 0, 0); PG8_STAGE(PG8_SA(1, 1), a1 + hstep, voffA);
            PG8_WAIT_L(8); PG8_BAR; PG8_WAIT_L(0); PG8_MMA(0, 0, At, B0); PG8_BAR; PG8_SCHED;
            PG8_LDB(B1, 0, 1); PG8_STAGE(PG8_SB(0, 0), b2, voffB);
            PG8_BAR; PG8_WAIT_L(0); PG8_MMA(0, 1, At, B1); PG8_BAR;
            PG8_LDA(At, 0, 1); PG8_STAGE(PG8_SA(0, 0), a2, voffA);
            PG8_BAR; PG8_WAIT_L(0); PG8_MMA(1, 0, At, B0); PG8_BAR; PG8_SCHED;
            PG8_STAGE(PG8_SB(0, 1), b2 + hstep, voffB);
            PG8_WAIT_V(6); PG8_BAR; PG8_MMA(1, 1, At, B1); PG8_BAR;
            PG8_LDB(B0, 1, 0); PG8_SCHED; PG8_LDA(At, 1, 0); PG8_STAGE(PG8_SA(0, 1), a2 + hstep, voffA);
            PG8_WAIT_L(8); PG8_BAR; PG8_WAIT_L(0); PG8_MMA(0, 0, At, B0); PG8_BAR; PG8_SCHED;
            PG8_LDB(B1, 1, 1); PG8_STAGE(PG8_SB(1, 0), b3, voffB);
            PG8_BAR; PG8_WAIT_L(0); PG8_MMA(0, 1, At, B1); PG8_BAR;
            PG8_LDA(At, 1, 1); PG8_STAGE(PG8_SA(1, 0), a3, voffA);
            PG8_BAR; PG8_WAIT_L(0); PG8_MMA(1, 0, At, B0); PG8_BAR; PG8_SCHED;
            PG8_STAGE(PG8_SB(1, 1), b3 + hstep, voffB);
            PG8_WAIT_V(6); PG8_BAR; PG8_MMA(1, 1, At, B1); PG8_BAR;
            }
        }
        if constexpr (ALIGN_EPI) { if (wr == 0) PG8_BAR; }
        if constexpr (!Epi::AFTER_DRAIN) { E(acc, cur, wr, wc, fr, fq); S.done(cur); }
        if (!has_next) break;
#pragma unroll
        for (int a = 0; a < 2; ++a)
#pragma unroll
            for (int b = 0; b < 2; ++b)
#pragma unroll
                for (int m = 0; m < 4; ++m)
#pragma unroll
                    for (int n = 0; n < 2; ++n) acc[a][b][m][n] = (f32x4){0.f, 0.f, 0.f, 0.f};
        cur = nxt; cA = nA; cB = nB; ++ui;
        if constexpr (ALIGN_EPI) { if (wr == 1) PG8_BAR; }
    }
    PG8_WAIT_V(0);
    if constexpr (!ALIGN_EPI) { if (wr == 0) PG8_BAR; }
    PG8_BAR;
    if constexpr (Epi::AFTER_DRAIN) { E.fused(acc, cur, wr, wc, fr, fq, lds, wid, lane); S.done(cur); }
#undef PG8_SA
#undef PG8_SB
#undef PG8_STAGE
#undef PG8_LDA
#undef PG8_LDB
#undef PG8_MMA
#undef PG8_WAIT_V
#undef PG8_WAIT_L
#undef PG8_BAR
#undef PG8_SCHED
}
}

#ifndef RP_DIL
#define RP_DIL 1
#endif
#ifndef RP_IDX
#define RP_IDX 1
#endif
#ifndef RP_DKV
#define RP_DKV 1
#endif
#ifndef RP_RKV
#define RP_RKV 1
#endif
#ifndef RP_ATT
#define RP_ATT 1
#endif
#ifndef RP_ROUT
#define RP_ROUT 1
#endif
#ifndef RP_SEL
#define RP_SEL 1
#endif
#ifndef RP_IDXMAIN
#define RP_IDXMAIN 1
#endif
#ifndef PROBE_ATOM
#define PROBE_ATOM 0
#endif
#ifndef PROBE_MFMA
#define PROBE_MFMA 0
#endif
#ifndef PROBE_PASSA
#define PROBE_PASSA 0
#endif
#ifndef PROBE_VALU
#define PROBE_VALU 0
#endif
#ifndef IDX_NW
#define IDX_NW 8
#endif
#ifndef REP_MIXA
#define REP_MIXA 1
#endif
#ifndef REP_MIXB
#define REP_MIXB 1
#endif
#ifndef REP_PRE
#define REP_PRE 1
#endif
#ifndef REP_GIN
#define REP_GIN 1
#endif
#ifndef REP_GUP
#define REP_GUP 1
#endif
#ifndef EN_RET
#define EN_RET 1
#endif
#ifndef EN_DSA
#define EN_DSA 1
#endif
#ifndef EN_DIL
#define EN_DIL 1
#endif
typedef unsigned short bf16_t;
typedef short bf16x8 __attribute__((ext_vector_type(8)));
typedef float f32x4 __attribute__((ext_vector_type(4)));
typedef float f32x16 __attribute__((ext_vector_type(16)));
typedef unsigned u32x4 __attribute__((ext_vector_type(4)));
typedef unsigned u32x2 __attribute__((ext_vector_type(2)));
constexpr int NB = 2, S = 8192, DM = 1024, DEPTH = 4, M = NB * S, DFF = 4096;
constexpr int NIN = 3528, NP = 3584;
constexpr int C_RQ = 0, C_RK = 256, C_RV = 512, C_RG = 768, C_DQ = 1024, C_CKV = 1280, C_QI = 1408, C_KI = 1920, C_WI = 1984, C_LQ = 2048, C_LK = 2560, C_LV = 3072;
constexpr float NORM_EPS = 1e-6f;
#define PJ(base, row, col) ((base) + ((size_t)((col) >> 6) * M + (size_t)(row)) * 64 + ((col) & 63))
constexpr size_t MiB = 1u << 20;
constexpr size_t WS_CTL = 0;
constexpr size_t WS_WKV = 1 * MiB;
constexpr size_t WS_WIN = 2 * MiB;
constexpr size_t WS_WOUT = 9 * MiB;
constexpr size_t WS_SLOTA = 12 * MiB;
constexpr size_t WS_XB = WS_SLOTA, WS_SSQ = 128 * 1024, WS_HX = WS_SLOTA, WS_SCR = WS_SLOTA, WS_XN = WS_SLOTA, WS_WUP = WS_SLOTA + 32 * MiB, WS_WDN = WS_SLOTA + 40 * MiB;
constexpr size_t SCR_PER_WG = 256 * 1024;
constexpr size_t WS_WIN2 = WS_SLOTA + 48 * MiB, WS_WOUT2 = WS_SLOTA + 55 * MiB, WS_WKV2 = WS_SLOTA + 58 * MiB;
#define WINB(l) (((l) & 1) ? WS_WIN2 : WS_WIN)
#define WOUTB(l) (((l) & 1) ? WS_WOUT2 : WS_WOUT)
#define WKVB(l) (((l) & 1) ? WS_WKV2 : WS_WKV)
constexpr size_t WS_MIXED = 76 * MiB;
constexpr size_t WS_PROJ = 108 * MiB;
constexpr size_t WS_HID = 108 * MiB;
constexpr size_t WS_KVT = 220 * MiB;
constexpr size_t WS_DK = 228 * MiB;
constexpr size_t WS_DVT = 236 * MiB;
constexpr size_t WS_BM = 244 * MiB;
constexpr size_t WS_END = 260 * MiB;
constexpr int LDS_BYTES = 147456;

__device__ __forceinline__ float bf2f(bf16_t v) { return __uint_as_float(((unsigned)v) << 16); }
__device__ __forceinline__ unsigned f2bf(float f) { unsigned u = __float_as_uint(f); return (u + 0x7fffu + ((u >> 16) & 1u)) >> 16; }
__device__ __forceinline__ unsigned pk2(float lo, float hi) { return f2bf(lo) | (f2bf(hi) << 16); }
__device__ __forceinline__ float wave_sum(float v) {
#pragma unroll
    for (int o = 1; o < 64; o <<= 1) v += __shfl_xor(v, o);
    return v;
}
__device__ __forceinline__ int crow(int r, int hi) { return (r & 3) + 8 * (r >> 2) + 4 * hi; }
__device__ __forceinline__ bf16x8 pack8(const float* p) { u32x4 w; w.x = pk2(p[0], p[1]); w.y = pk2(p[2], p[3]); w.z = pk2(p[4], p[5]); w.w = pk2(p[6], p[7]); return __builtin_bit_cast(bf16x8, w); }
__device__ __forceinline__ bf16x8 join8(u32x2 a, u32x2 b) { u32x4 w; w.x = a.x; w.y = a.y; w.z = b.x; w.w = b.y; return __builtin_bit_cast(bf16x8, w); }
__device__ __forceinline__ unsigned cvtpk(float lo, float hi) { typedef float f2_t __attribute__((ext_vector_type(2))); typedef __bf16 b2_t __attribute__((ext_vector_type(2))); f2_t v = {lo, hi}; b2_t bb = __builtin_convertvector(v, b2_t); return __builtin_bit_cast(unsigned, bb); }
__device__ __forceinline__ bf16x8 pack8h(const float* p) { u32x4 w; w.x = cvtpk(p[0], p[1]); w.y = cvtpk(p[2], p[3]); w.z = cvtpk(p[4], p[5]); w.w = cvtpk(p[6], p[7]); return __builtin_bit_cast(bf16x8, w); }
__device__ __forceinline__ float fmx(float a, float b) { return __builtin_elementwise_maximum(a, b); }
__device__ __forceinline__ float xhalf_max(float v) { auto rr = __builtin_amdgcn_permlane32_swap(__float_as_uint(v), __float_as_uint(v), false, false); return fmx(__uint_as_float(rr[0]), __uint_as_float(rr[1])); }
__device__ __forceinline__ float xhalf_sum(float v) { auto rr = __builtin_amdgcn_permlane32_swap(__float_as_uint(v), __float_as_uint(v), false, false); return __uint_as_float(rr[0]) + __uint_as_float(rr[1]); }
__device__ __forceinline__ int vperm32(int kk) { return (kk & 16) | ((kk & 4) << 1) | ((kk & 8) >> 1) | (kk & 3); }
__device__ __forceinline__ float max0(float x) { return __builtin_amdgcn_fmed3f(x, 0.f, __builtin_inff()); }
#define MFMA32(a, b, c) __builtin_amdgcn_mfma_f32_32x32x16_bf16((a), (b), (c), 0, 0, 0)
#define LDSW() asm volatile("s_waitcnt lgkmcnt(0)" ::: "memory")
#define LDSO() asm volatile("" ::: "memory")

template <int MODE, bool SCALE>
__device__ __forceinline__ void transpose_item(const float* __restrict__ W, int K, int N, bf16_t* WT, int nblk, float* scr, int item, int lane, const float* kscale = nullptr) {
    const int kb = item / nblk, nb = item % nblk, k0 = 64 * kb, n0 = 32 * nb;
    const int n = n0 + (lane & 31);
    int sc = n; if (MODE == 1) sc = (n < 1992) ? n : ((n < 2048) ? -1 : n - 56);
    const float keep = (sc >= 0) ? 1.f : 0.f; const int scc = (sc >= 0) ? sc : 0;
    const float* src = W + (size_t)(k0 + (lane >> 5)) * N + scc;
    float wv[32];
#pragma unroll
    for (int i = 0; i < 32; ++i) wv[i] = src[(size_t)(2 * i) * N];
    if (SCALE) {
        float ks[32];
#pragma unroll
        for (int i = 0; i < 32; ++i) ks[i] = kscale[k0 + 2 * i + (lane >> 5)];
#pragma unroll
        for (int i = 0; i < 32; ++i) wv[i] *= ks[i];
    }
#pragma unroll
    for (int i = 0; i < 32; ++i) scr[(2 * i + (lane >> 5)) * 33 + (lane & 31)] = wv[i] * keep;
    LDSW();
    const int c = lane & 7;
#pragma unroll
    for (int j = 0; j < 4; ++j) { const int nn = (lane >> 3) + 8 * j; const float* s = scr + (8 * c) * 33 + nn;
        u32x4 o; o.x = pk2(s[0 * 33], s[1 * 33]); o.y = pk2(s[2 * 33], s[3 * 33]); o.z = pk2(s[4 * 33], s[5 * 33]); o.w = pk2(s[6 * 33], s[7 * 33]);
        *(u32x4*)(WT + (size_t)(n0 + nn) * K + k0 + 8 * c) = o; }
    LDSW();
}
__device__ __forceinline__ void rms_row_bf16(const float* xrow, const float* w, bf16_t* orow, int lane) {
    const f32x4* xr = (const f32x4*)xrow + lane; const f32x4* wr = (const f32x4*)w + lane;
    f32x4 v[4]; float s = 0.f;
#pragma unroll
    for (int j = 0; j < 4; ++j) { v[j] = xr[64 * j]; s += (v[j].x * v[j].x + v[j].y * v[j].y) + (v[j].z * v[j].z + v[j].w * v[j].w); }
    const float rstd = rsqrtf(wave_sum(s) * (1.f / DM) + NORM_EPS);
    u32x2* o8 = (u32x2*)orow + lane;
#pragma unroll
    for (int j = 0; j < 4; ++j) { const f32x4 ww = wr[64 * j]; u32x2 o; o.x = pk2(v[j].x * rstd * ww.x, v[j].y * rstd * ww.y); o.y = pk2(v[j].z * rstd * ww.z, v[j].w * rstd * ww.w); o8[64 * j] = o; }
}
__device__ __forceinline__ void row_xb_ssq(const float* xrow, bf16_t* orow, float* ssq, int lane) {
    const f32x4* xr = (const f32x4*)xrow + lane;
    f32x4 v[4]; float s = 0.f;
#pragma unroll
    for (int j = 0; j < 4; ++j) { v[j] = xr[64 * j]; s += (v[j].x * v[j].x + v[j].y * v[j].y) + (v[j].z * v[j].z + v[j].w * v[j].w); }
    s = wave_sum(s);
    u32x2* o8 = (u32x2*)orow + lane;
#pragma unroll
    for (int j = 0; j < 4; ++j) { u32x2 o; o.x = cvtpk(v[j].x, v[j].y); o.y = cvtpk(v[j].z, v[j].w); o8[64 * j] = o; }
    if (lane == 0) __hip_atomic_store((unsigned*)ssq, (unsigned)(s * 1024.f + 0.5f), __ATOMIC_RELAXED, __HIP_MEMORY_SCOPE_AGENT);
}
__device__ __forceinline__ void final_row(const bf16_t* xrow, const float* w, const float* ssq, float* orow, int lane) {
    const float rstd = rsqrtf((float)__hip_atomic_load((const unsigned*)ssq, __ATOMIC_RELAXED, __HIP_MEMORY_SCOPE_AGENT) * (1.f / (1024.f * DM)) + NORM_EPS);
#pragma unroll
    for (int j = 0; j < 2; ++j) { const u32x4 b = *((const u32x4*)xrow + lane + 64 * j); const f32x4* wr = (const f32x4*)w + 2 * lane + 128 * j; f32x4* o = (f32x4*)orow + 2 * lane + 128 * j;
        const f32x4 w0 = wr[0], w1 = wr[1]; f32x4 o0, o1;
        o0.x = __uint_as_float(b.x << 16) * rstd * w0.x; o0.y = __uint_as_float(b.x & 0xffff0000u) * rstd * w0.y; o0.z = __uint_as_float(b.y << 16) * rstd * w0.z; o0.w = __uint_as_float(b.y & 0xffff0000u) * rstd * w0.w;
        o1.x = __uint_as_float(b.z << 16) * rstd * w1.x; o1.y = __uint_as_float(b.z & 0xffff0000u) * rstd * w1.y; o1.z = __uint_as_float(b.w << 16) * rstd * w1.z; o1.w = __uint_as_float(b.w & 0xffff0000u) * rstd * w1.w;
        o[0] = o0; o[1] = o1; }
}
__device__ __forceinline__ void rms_row_f32(const float* xrow, const float* w, float* orow, int lane) {
    const f32x4* xr = (const f32x4*)xrow + lane; const f32x4* wr = (const f32x4*)w + lane;
    f32x4 v[4]; float s = 0.f;
#pragma unroll
    for (int j = 0; j < 4; ++j) { v[j] = xr[64 * j]; s += (v[j].x * v[j].x + v[j].y * v[j].y) + (v[j].z * v[j].z + v[j].w * v[j].w); }
    const float rstd = rsqrtf(wave_sum(s) * (1.f / DM) + NORM_EPS);
    f32x4* o = (f32x4*)orow + lane;
#pragma unroll
    for (int j = 0; j < 4; ++j) { const f32x4 ww = wr[64 * j]; o[64 * j] = v[j] * rstd * ww; }
}
__device__ __forceinline__ void rot_cs(int pos, int i, float& c, float& s) {
    const float inv = exp2f(-(float)i * (13.287712379549449f / 32.f));
    float t = ((float)pos * inv) * 0.15915494309189535f; t = t - floorf(t);
    s = __builtin_amdgcn_sinf(t); c = __builtin_amdgcn_cosf(t);
}
__device__ __forceinline__ float log2_gamma(int h) { return log2f(1.f - exp2f(-5.f - (float)h)); }

__device__ __forceinline__ const bf16_t* dil_frag(const bf16_t* proj, int col, int b, int t, int hi) {
    const int pr = b * S + (t & 15) * 512 + (t >> 4);
    return proj + (size_t)(col >> 6) * M * 64 + (size_t)(pr >> 5) * 2048 + (hi * 32 + (pr & 31)) * 8;
}
#define LASP __attribute__((address_space(3)))
typedef short v4i16_t __attribute__((ext_vector_type(4)));
__device__ __forceinline__ u32x2 ldtr(LASP const unsigned char* p) { return __builtin_bit_cast(u32x2, __builtin_amdgcn_ds_read_tr16_b64_v4i16((LASP v4i16_t*)p)); }
__device__ __forceinline__ void dil_item(unsigned char* lds_g, const bf16_t* proj, bf16_t* mixed, int item, int tid, int lane, int wid) {
    LASP unsigned char* lds = (LASP unsigned char*)lds_g;
    const int b = item >> 7, h = (item >> 4) & 7, blk = item & 15, t0 = blk * 512;
    LASP float* lsebuf = (LASP float*)lds;
    LASP unsigned char* obuf = lds + 2048;
    LASP unsigned char* vt = lds + 2048 + 65536 + wid * 4096;
    const int r32 = lane & 31, hi = lane >> 5;
    const int rb = b * S;
    const int vwr = r32 * 64 + 16 * hi;
    const int vrd = (4 * hi + ((lane & 15) >> 2)) * 64 + (16 * ((lane >> 4) & 1) + 4 * (lane & 3)) * 2;
    for (int br = 0; br < 3; ++br) {
        const int sh = 2 * br, dl = 1 << sh;
        const int rhoA = wid & (dl - 1), I0A = (t0 >> sh) + 32 * (wid >> sh), rhoB = (wid + 8) & (dl - 1), I0B = (t0 >> sh) + 32 * ((wid + 8) >> sh);
        const int kk0A = (I0A >= 128) ? 0 : (4 - (I0A >> 5)), kk0B = (I0B >= 128) ? 0 : (4 - (I0B >> 5));
        bf16x8 QA[4], QB[4];
        { const bf16_t* qa = dil_frag(proj, C_LQ + h * 64, b, rhoA + dl * (I0A + r32), hi); const bf16_t* qb = dil_frag(proj, C_LQ + h * 64, b, rhoB + dl * (I0B + r32), hi);
#pragma unroll
          for (int ks = 0; ks < 4; ++ks) { QA[ks] = *(const bf16x8*)(qa + 512 * ks); QB[ks] = *(const bf16x8*)(qb + 512 * ks); } }
        bf16x8 K0[4], K1[4], V0[4], V1[4]; f32x16 s0, s1;
#define DIL_RHO(i_) (((i_) < 5) ? rhoA : rhoB)
#define DIL_I0(i_) (((i_) < 5) ? I0A : I0B)
#define DIL_POS(i_) ({ const int ii_ = ((i_) < 10) ? (i_) : 9; int p_ = DIL_RHO(ii_) + dl * (DIL_I0(ii_) - 128 + 32 * (ii_ % 5) + r32); p_ < 0 ? 0 : p_; })
#define DIL_LOADK(K_, i_) do { const bf16_t* kp_ = dil_frag(proj, C_LK + h * 64, b, DIL_POS(i_), hi); _Pragma("unroll") for (int c = 0; c < 4; ++c) K_[c] = *(const bf16x8*)(kp_ + 512 * c); } while (0)
#define DIL_LOADV(V_, i_) do { const bf16_t* vp_ = dil_frag(proj, C_LV + h * 64, b, DIL_POS(i_), hi); _Pragma("unroll") for (int c = 0; c < 4; ++c) V_[c] = *(const bf16x8*)(vp_ + 512 * c); } while (0)
#define DIL_QK(s_, K_, i_) do { s_ = (f32x16){}; _Pragma("unroll") for (int ks = 0; ks < 4; ++ks) s_ = MFMA32(K_[ks], ((i_) < 5 ? QA[ks] : QB[ks]), s_); } while (0)
#define DIL_STEP(i_, sC, sN, KC, KN, VC, VN) do { constexpr int kk = (i_) % 5; const int kk0u = ((i_) < 5) ? kk0A : kk0B; \
        if (kk == 0) { o0 = (f32x16){}; o1 = (f32x16){}; m = -1e30f; l = 0.f; } \
        DIL_LOADK(KC, (i_) + 2); DIL_LOADV(VN, (i_) + 1); \
        if ((i_) + 1 < 10) DIL_QK(sN, KN, (i_) + 1); \
        if (kk >= kk0u) { \
            _Pragma("unroll") for (int c = 0; c < 4; ++c) *(LASP bf16x8*)(vt + (c >> 1) * 2048 + (c & 1) * 32 + vwr) = VC[c]; \
            float x[16], p[16]; float tmax = -1e30f; \
            if (kk == 0 || kk == 4) { \
                _Pragma("unroll") for (int r = 0; r < 16; ++r) { const int j = crow(r, hi); const bool ok = (kk == 0) ? (j >= r32) : (j <= r32); \
                    x[r] = ok ? sC[r] * (0.125f * 1.4426950408889634f) : -1e30f; tmax = fmx(tmax, x[r]); } \
            } else { \
                _Pragma("unroll") for (int r = 0; r < 16; ++r) { x[r] = sC[r] * (0.125f * 1.4426950408889634f); tmax = fmx(tmax, x[r]); } } \
            tmax = xhalf_max(tmax); \
            if (__any(tmax > m + 6.f)) { const float mn = fmx(m, tmax), alpha = __builtin_amdgcn_exp2f(m - mn); o0 = o0 * alpha; o1 = o1 * alpha; l *= alpha; m = mn; }     \
            float psum = 0.f; \
            _Pragma("unroll") for (int r = 0; r < 16; ++r) { p[r] = __builtin_amdgcn_exp2f(x[r] - m); psum += p[r]; } \
            l += psum; \
            const bf16x8 P0 = pack8h(p), P1 = pack8h(p + 8); \
            LDSO(); \
            { const u32x2 a00 = ldtr(vt + vrd), a01 = ldtr(vt + vrd + 512), a10 = ldtr(vt + vrd + 1024), a11 = ldtr(vt + vrd + 1536); \
              const u32x2 b00 = ldtr(vt + vrd + 2048), b01 = ldtr(vt + vrd + 2048 + 512), b10 = ldtr(vt + vrd + 2048 + 1024), b11 = ldtr(vt + vrd + 2048 + 1536); \
              o0 = MFMA32(join8(a00, a01), P0, o0); o0 = MFMA32(join8(a10, a11), P1, o0); \
              o1 = MFMA32(join8(b00, b01), P0, o1); o1 = MFMA32(join8(b10, b11), P1, o1); } \
            LDSO(); \
        } \
        if (kk == 4) DIL_EPI(DIL_RHO(i_) + dl * (DIL_I0(i_) + r32)); } while (0)
#define DIL_EPI(posq_) do { const int posq = (posq_); \
        l = xhalf_sum(l); \
        float inv = 1.f / l; const int pl = posq - t0; \
        float lse = (m + __builtin_amdgcn_logf(l)) * 0.6931471805599453f; \
        LASP unsigned char* orow = obuf + pl * 128 + hi * 32; \
        float wprev = 0.f; \
        if (br > 0) { const float lp = lsebuf[pl]; const float mx = fmx(lp, lse); const float wa = __expf(lp - mx), wb = __expf(lse - mx); const float iv = 1.f / (wa + wb); \
            wprev = wa * iv; inv *= wb * iv; lse = mx + __logf(wa + wb); } \
        float f0[16], f1[16]; \
        _Pragma("unroll") for (int r = 0; r < 16; ++r) { f0[r] = o0[r] * inv; f1[r] = o1[r] * inv; } \
        if (br > 0) { \
            const u32x4 q0 = *(LASP const u32x4*)(orow), q1 = *(LASP const u32x4*)(orow + 16), q2 = *(LASP const u32x4*)(orow + 64), q3 = *(LASP const u32x4*)(orow + 80); \
            const unsigned wa[8] = {q0.x, q0.y, q0.z, q0.w, q1.x, q1.y, q1.z, q1.w}, wb[8] = {q2.x, q2.y, q2.z, q2.w, q3.x, q3.y, q3.z, q3.w}; \
            _Pragma("unroll") for (int i = 0; i < 8; ++i) { f0[2 * i] += wprev * __uint_as_float(wa[i] << 16); f0[2 * i + 1] += wprev * __uint_as_float(wa[i] & 0xffff0000u); \
                f1[2 * i] += wprev * __uint_as_float(wb[i] << 16); f1[2 * i + 1] += wprev * __uint_as_float(wb[i] & 0xffff0000u); } } \
        if (br < 2) { \
            if (hi == 0) lsebuf[pl] = lse; \
            u32x4 w0, w1, w2, w3; \
            w0.x = cvtpk(f0[0], f0[1]); w0.y = cvtpk(f0[2], f0[3]); w0.z = cvtpk(f0[4], f0[5]); w0.w = cvtpk(f0[6], f0[7]); \
            w1.x = cvtpk(f0[8], f0[9]); w1.y = cvtpk(f0[10], f0[11]); w1.z = cvtpk(f0[12], f0[13]); w1.w = cvtpk(f0[14], f0[15]); \
            w2.x = cvtpk(f1[0], f1[1]); w2.y = cvtpk(f1[2], f1[3]); w2.z = cvtpk(f1[4], f1[5]); w2.w = cvtpk(f1[6], f1[7]); \
            w3.x = cvtpk(f1[8], f1[9]); w3.y = cvtpk(f1[10], f1[11]); w3.z = cvtpk(f1[12], f1[13]); w3.w = cvtpk(f1[14], f1[15]); \
            *(LASP u32x4*)(orow) = w0; *(LASP u32x4*)(orow + 16) = w1; *(LASP u32x4*)(orow + 64) = w2; *(LASP u32x4*)(orow + 80) = w3; \
        } else { \
            bf16_t* og = mixed + (size_t)(rb + posq) * DM + 512 + h * 64 + 4 * hi; \
            _Pragma("unroll") for (int g = 0; g < 4; ++g) { u32x2 a, c; a.x = cvtpk(f0[4 * g], f0[4 * g + 1]); a.y = cvtpk(f0[4 * g + 2], f0[4 * g + 3]); c.x = cvtpk(f1[4 * g], f1[4 * g + 1]); c.y = cvtpk(f1[4 * g + 2], f1[4 * g + 3]); \
                *(u32x2*)(og + 8 * g) = a; *(u32x2*)(og + 32 + 8 * g) = c; } } } while (0)
        f32x16 o0 = {}, o1 = {}; float m = -1e30f, l = 0.f;
        DIL_LOADK(K0, 0); DIL_LOADV(V0, 0); DIL_LOADK(K1, 1);
        DIL_QK(s0, K0, 0);
        DIL_STEP(0, s0, s1, K0, K1, V0, V1); DIL_STEP(1, s1, s0, K1, K0, V1, V0); DIL_STEP(2, s0, s1, K0, K1, V0, V1); DIL_STEP(3, s1, s0, K1, K0, V1, V0); DIL_STEP(4, s0, s1, K0, K1, V0, V1);
        DIL_STEP(5, s1, s0, K1, K0, V1, V0); DIL_STEP(6, s0, s1, K0, K1, V0, V1); DIL_STEP(7, s1, s0, K1, K0, V1, V0); DIL_STEP(8, s0, s1, K0, K1, V0, V1); DIL_STEP(9, s1, s0, K1, K0, V1, V0);
#undef DIL_RHO
#undef DIL_I0
#undef DIL_POS
#undef DIL_LOADK
#undef DIL_LOADV
#undef DIL_QK
#undef DIL_STEP
#undef DIL_EPI
        __syncthreads();
    }
}

__device__ __forceinline__ void find_bin(LASP const unsigned* hist, int lane, unsigned need, unsigned& bin, unsigned& need_in_bin, unsigned& cnt_in_bin) {
    const u32x4 h = *(LASP const u32x4*)(hist + 4 * lane); const unsigned tl = h.x + h.y + h.z + h.w;
    unsigned P = tl;
    P += (unsigned)__builtin_amdgcn_update_dpp(0, (int)P, 0x111, 0xf, 0xf, false);
    P += (unsigned)__builtin_amdgcn_update_dpp(0, (int)P, 0x112, 0xf, 0xf, false);
    P += (unsigned)__builtin_amdgcn_update_dpp(0, (int)P, 0x114, 0xf, 0xf, false);
    P += (unsigned)__builtin_amdgcn_update_dpp(0, (int)P, 0x118, 0xf, 0xf, false);
    P += (unsigned)__builtin_amdgcn_update_dpp(0, (int)P, 0x142, 0xa, 0xf, false);
    P += (unsigned)__builtin_amdgcn_update_dpp(0, (int)P, 0x143, 0xc, 0xf, false);
    const unsigned total = (unsigned)__builtin_amdgcn_readlane((int)P, 63);
    const unsigned above = total - P, suf = above + tl;
    const bool found = (above < need) && (suf >= need);
    const unsigned long long mk = __ballot(found);
    const int fl = __builtin_amdgcn_readfirstlane(mk ? (int)__builtin_ctzll(mk) : 0);
    const unsigned a = (unsigned)__builtin_amdgcn_readlane((int)above, fl), hx = (unsigned)__builtin_amdgcn_readlane((int)h.x, fl), hy = (unsigned)__builtin_amdgcn_readlane((int)h.y, fl), hz = (unsigned)__builtin_amdgcn_readlane((int)h.z, fl), hw = (unsigned)__builtin_amdgcn_readlane((int)h.w, fl);
    unsigned nd = need - a; unsigned bb, cc;
    if (hw >= nd) { bb = 3; cc = hw; } else { nd -= hw; if (hz >= nd) { bb = 2; cc = hz; } else { nd -= hz; if (hy >= nd) { bb = 1; cc = hy; } else { nd -= hy; bb = 0; cc = hx; } } }
    bin = 4 * fl + bb; need_in_bin = nd; cnt_in_bin = cc;
}
typedef unsigned short us2_t __attribute__((ext_vector_type(2)));
__device__ __forceinline__ void sel_row(const u32x4 (&v)[16], LASP const unsigned* hist, LASP unsigned* hist2, unsigned char* bm, int b, int q0, int ql, int wid, int lane, unsigned zz) {
        const int qpos = q0 + ql, nvalid = qpos + 1, nch = (nvalid + 511) >> 9;
        unsigned Tc = 0u, Teq = 0u, rr = 0u; bool ties = false;
        if (nvalid > 256) {
            unsigned bin, need2, cb; find_bin(hist + ql * 256, lane, 256u, bin, need2, cb);
            LASP unsigned* h2 = hist2 + wid * 256;
            *(LASP u32x4*)(h2 + 4 * lane) = (u32x4){zz, zz, zz, zz};
            LDSW();
            const unsigned xb = (bin << 8) | (bin << 24);
#pragma unroll
            for (int c = 0; c < 16; ++c) if (c < nch) {
                unsigned f = 0u;
#pragma unroll
                for (int d = 3; d >= 0; --d) { const unsigned w = d == 0 ? v[c].x : (d == 1 ? v[c].y : (d == 2 ? v[c].z : v[c].w)); const unsigned t = w ^ xb;
                    f = (f << 1) | ((((t - 0x01000100u) & ~t) & 0x80008000u) >> 15); }
                while (f) { const int pb = __builtin_ctz(f); f &= f - 1u; const unsigned d = pb & 3, hf = pb >> 4;
                    const unsigned m1 = 0u - (d & 1u), m2 = 0u - (d >> 1);
                    const unsigned lo_ = (v[c].x & ~m1) | (v[c].y & m1), hi_ = (v[c].z & ~m1) | (v[c].w & m1), w = (lo_ & ~m2) | (hi_ & m2); const unsigned k = (w >> (16u * hf)) & 0xffffu;
                    if ((k >> 8) == bin && 512 * c + 8 * lane + 2 * (int)d + (int)hf <= qpos) __hip_atomic_fetch_add(&h2[k & 255u], 1u, __ATOMIC_RELAXED, __HIP_MEMORY_SCOPE_WORKGROUP); }
            }
            LDSW();
            unsigned tb, r2, ce; find_bin(h2, lane, need2, tb, r2, ce);
            Teq = (bin << 8) | tb;
            if (r2 == ce) { Tc = Teq - 1u; } else { Tc = Teq; ties = true; rr = r2; }
        }
        unsigned tc = 0u; const unsigned Tc2 = Tc | (Tc << 16);
        unsigned char* brow = bm + ((size_t)(b * 256 + (qpos >> 5)) * 256 * 32 + (qpos & 31)) * 4;
#pragma unroll
        for (int c = 0; c < 16; ++c) if (c < nch) {
            int cnt = qpos - (512 * c + 8 * lane) + 1; cnt = cnt < 0 ? 0 : (cnt > 8 ? 8 : cnt);
            const unsigned vm = (1u << cnt) - 1u;
            unsigned acc2 = 0u;
#pragma unroll
            for (int d = 3; d >= 0; --d) { const unsigned w = d == 0 ? v[c].x : (d == 1 ? v[c].y : (d == 2 ? v[c].z : v[c].w)); unsigned df, e;
                asm("v_pk_sub_u16 %0, %1, %2 clamp" : "=v"(df) : "v"(w), "v"(Tc2)); asm("v_pk_min_u16 %0, %1, %2" : "=v"(e) : "v"(df), "v"(0x00010001u));
                acc2 = (acc2 << 2) | e; }
            unsigned byte = (acc2 | (acc2 >> 15)) & 0xffu;
            byte &= vm;
            if (ties) {
                unsigned tieb = 0u;
#pragma unroll
                for (int j = 0; j < 8; ++j) { const unsigned w = (j >> 1) == 0 ? v[c].x : ((j >> 1) == 1 ? v[c].y : ((j >> 1) == 2 ? v[c].z : v[c].w)); const unsigned k = (j & 1) ? (w >> 16) : (w & 0xffffu);
                    tieb |= (k == Teq ? 1u : 0u) << j; }
                tieb &= vm;
                if (__any(tieb != 0u)) {
                    const unsigned nt = __builtin_popcount(tieb);
                    unsigned inc = nt;
#pragma unroll
                    for (int o = 1; o < 64; o <<= 1) { const unsigned t = __shfl_up(inc, o); if (lane >= o) inc += t; }
                    unsigned rank = tc + inc - nt;
#pragma unroll
                    for (int j = 0; j < 8; ++j) if (tieb & (1u << j)) { if (rank < rr) byte |= (1u << j); ++rank; }
                    tc += __shfl(inc, 63);
                }
            }
            { const int bi = 64 * c + lane; brow[(size_t)(bi >> 2) * 128 + (bi & 3)] = (unsigned char)byte; }
        }
}
typedef __fp16 h2_t __attribute__((ext_vector_type(2)));
__device__ __forceinline__ void idx_item(unsigned char* lds_g, const bf16_t* proj, bf16_t* sc, unsigned char* bm, int b, int qt, int tid, int lane, int wid) {
    asm volatile("" : "+v"(tid)); lane = tid & 63;
    LASP unsigned char* lds = (LASP unsigned char*)lds_g;
    const int q0 = qt * 16, r32 = lane & 31, hi = lane >> 5;
    LASP unsigned* hist = (LASP unsigned*)lds;
    LASP unsigned* hist2 = hist + 16 * 256;
    LASP float* wl = (LASP float*)(hist2 + 8 * 256);
    LASP bf16_t* linA = (LASP bf16_t*)(wl + 128);
    LASP unsigned short* stage = (LASP unsigned short*)(linA + 16 * 64) + wid * 512;
    const int rb = b * S;
    bf16x8 A[4][4];
    { const int ql = r32 >> 4, hq = (r32 >> 2) & 1, head = (r32 & 3) + 4 * ((r32 >> 3) & 1);
#pragma unroll
      for (int rt = 0; rt < 4; ++rt) { const bf16_t* p = PJ(proj, rb + q0 + 4 * rt + 2 * hq + ql, C_QI + head * 64) + 8 * hi;
#pragma unroll
          for (int ks = 0; ks < 4; ++ks) A[rt][ks] = *(const bf16x8*)(p + 16 * ks); } }
    const int nkt = (q0 + 15) / 32 + 1;
    const bf16_t* kbase = proj + (size_t)(C_KI >> 6) * M * 64 + (size_t)(rb >> 5) * 2048 + (hi * 32 + r32) * 8;
    bf16x8 Ba[4], Bb[4];
#define IDX_LOAD(B_, kt_) do { const bf16_t* kp_ = kbase + (size_t)(kt_) * 2048; _Pragma("unroll") for (int ks = 0; ks < 4; ++ks) B_[ks] = *(const bf16x8*)(kp_ + 512 * ks); } while (0)
    IDX_LOAD(Ba, (wid < nkt) ? wid : (nkt - 1));
    for (int i = tid; i < 16 * 256; i += 512) hist[i] = 0u;
    {
        const int q = tid >> 5, d2 = 2 * (tid & 31);
        const bf16x8 w8 = *(const bf16x8*)PJ(proj, rb + q0 + q, C_WI);
        unsigned qv[8];
#pragma unroll
        for (int hd = 0; hd < 8; ++hd) qv[hd] = *(const unsigned*)(PJ(proj, rb + q0 + q, C_QI + hd * 64) + d2);
        float l0 = 0.f, l1 = 0.f, mine = 0.f;
#pragma unroll
        for (int hd = 0; hd < 8; ++hd) { const float c = bf2f((bf16_t)w8[hd]) * (0.5f * 0.04419417382415922f * (4096.f / 65535.f));
            l0 = fmaf(c, __uint_as_float(qv[hd] << 16), l0); l1 = fmaf(c, __uint_as_float(qv[hd] & 0xffff0000u), l1); mine = ((tid & 31) == hd) ? c : mine; }
        if ((tid & 31) < 8) wl[q * 8 + (tid & 31)] = mine;
        *(LASP unsigned*)(linA + q * 64 + d2) = cvtpk(l0, l1);
    }
    __syncthreads();
    bf16x8 AL[4];
    { const int r = (r32 & 3) + 4 * ((r32 >> 3) & 1), hq = (r32 >> 2) & 1, ql = 4 * (r >> 1) + 2 * hq + (r & 1);
#pragma unroll
      for (int ks = 0; ks < 4; ++ks) { AL[ks] = *(LASP const bf16x8*)(linA + ql * 64 + 16 * ks + 8 * hi); if (r32 >= 16) AL[ks] = (bf16x8){0, 0, 0, 0, 0, 0, 0, 0}; } }
    const unsigned hb = (unsigned)(size_t)(hist + 2 * hi * 256);
    LASP unsigned short* sbase = stage + 2 * hi * 32 + r32;
    LASP const float* wbase = wl + 2 * hi * 8;
    bf16_t* gst = sc + (size_t)(lane >> 2) * 8192 + 8 * (lane & 3);
#define IDX_CHAIN(acc_, rt_, B_) do { acc_ = (f32x16){}; _Pragma("unroll") for (int ks = 0; ks < 4; ++ks) acc_ = MFMA32(A[rt_][ks], B_[ks], acc_); } while (0)
#define IDX_EPI(acc_, rt_, EDGE_) do { float s2_[2]; f32x4 cw_[2][2]; \
        _Pragma("unroll") for (int q2 = 0; q2 < 2; ++q2) { cw_[q2][0] = *(LASP const f32x4*)(wbase + (4 * rt_ + q2) * 8); cw_[q2][1] = *(LASP const f32x4*)(wbase + (4 * rt_ + q2) * 8 + 4); }     \
        __builtin_amdgcn_s_waitcnt(0xC07F);     \
        _Pragma("unroll") for (int q2 = 0; q2 < 2; ++q2) { const f32x4 c0 = cw_[q2][0], c1 = cw_[q2][1]; \
            float sv = lin[2 * rt_ + q2]; \
            sv = fmaf(__builtin_fabsf(acc_[8 * q2 + 0]), c0.x, sv); sv = fmaf(__builtin_fabsf(acc_[8 * q2 + 1]), c0.y, sv); sv = fmaf(__builtin_fabsf(acc_[8 * q2 + 2]), c0.z, sv); sv = fmaf(__builtin_fabsf(acc_[8 * q2 + 3]), c0.w, sv); \
            sv = fmaf(__builtin_fabsf(acc_[8 * q2 + 4]), c1.x, sv); sv = fmaf(__builtin_fabsf(acc_[8 * q2 + 5]), c1.y, sv); sv = fmaf(__builtin_fabsf(acc_[8 * q2 + 6]), c1.z, sv); sv = fmaf(__builtin_fabsf(acc_[8 * q2 + 7]), c1.w, sv); s2_[q2] = sv; } \
        us2_t kk2_ = __builtin_amdgcn_cvt_pknorm_u16(s2_[0], s2_[1]); kk2_ = __builtin_elementwise_max(kk2_, (us2_t){1, 1});     \
        const unsigned kk_ = __builtin_bit_cast(unsigned, kk2_); \
        unsigned one0 = 1u, one1 = 1u; if (EDGE_) { one0 = (key <= q0 + 4 * rt_ + 2 * hi) ? 1u : 0u; one1 = (key <= q0 + 4 * rt_ + 2 * hi + 1) ? 1u : 0u; }     \
        __hip_atomic_fetch_add((LASP unsigned*)(((kk_ >> 6) & 0x3fcu) | hb) + (4 * rt_) * 256, one0, __ATOMIC_RELAXED, __HIP_MEMORY_SCOPE_WORKGROUP); \
        __hip_atomic_fetch_add((LASP unsigned*)(((kk_ >> 22) & 0x3fcu) | hb) + (4 * rt_ + 1) * 256, one1, __ATOMIC_RELAXED, __HIP_MEMORY_SCOPE_WORKGROUP); \
        sbase[(4 * rt_) * 32] = (unsigned short)kk_; sbase[(4 * rt_ + 1) * 32] = (unsigned short)(kk_ >> 16); } while (0)
#define IDX_COMPUTE_(B_, kt_, EDGE_) do { const int key = 32 * (kt_) + r32; f32x16 ac0, ac1, lin; _Pragma("unroll") for (int e_ = 0; e_ < 16; ++e_) lin[e_] = 0.5f;     \
        _Pragma("unroll") for (int ks = 0; ks < 4; ++ks) lin = MFMA32(AL[ks], B_[ks], lin); \
        IDX_CHAIN(ac0, 0, B_); IDX_CHAIN(ac1, 1, B_); IDX_EPI(ac0, 0, EDGE_); IDX_CHAIN(ac0, 2, B_); IDX_EPI(ac1, 1, EDGE_); IDX_CHAIN(ac1, 3, B_); IDX_EPI(ac0, 2, EDGE_); IDX_EPI(ac1, 3, EDGE_); \
        LDSW(); const u32x4 sv4 = *(LASP const u32x4*)((LASP const unsigned char*)stage + lane * 16); asm volatile("" ::: "memory"); *(u32x4*)(gst + 32 * (kt_)) = sv4; } while (0)
#define IDX_COMPUTE(B_, kt_) do { if (32 * (kt_) + 31 <= q0) IDX_COMPUTE_(B_, kt_, false); else IDX_COMPUTE_(B_, kt_, true); } while (0)
    for (int rm_ = 0; rm_ < RP_IDXMAIN; ++rm_) {
    if (rm_) { __syncthreads(); for (int i = tid; i < 16 * 256; i += 512) hist[i] = 0u; __syncthreads(); }
    if (wid < nkt && wid < IDX_NW) {
        for (int kt = wid; kt < nkt; kt += 2 * IDX_NW) {
            { const int k1 = (kt + IDX_NW < nkt) ? kt + IDX_NW : kt; IDX_LOAD(Bb, k1); }
            IDX_COMPUTE(Ba, kt);
            { const int k2 = (kt + 2 * IDX_NW < nkt) ? kt + 2 * IDX_NW : kt; IDX_LOAD(Ba, k2); }
            if (kt + IDX_NW < nkt) IDX_COMPUTE(Bb, kt + IDX_NW); }
    }
    }
#undef IDX_LOAD
#undef IDX_CHAIN
#undef IDX_EPI
#undef IDX_COMPUTE
#undef IDX_COMPUTE_
    __syncthreads();
    for (int rs_ = 0; rs_ < RP_SEL; ++rs_) {
        u32x4 va[16], vb[16];
        unsigned zz = 0u; asm volatile("" : "+v"(zz));
        const int qlA = 2 * wid, nchB = (q0 + qlA + 2 + 511) >> 9;
        const bf16_t* rowA = sc + qlA * 8192 + lane * 8;
#pragma unroll
        for (int c = 0; c < 16; ++c) { if (c < nchB) { va[c] = *(const u32x4*)(rowA + 512 * c); vb[c] = *(const u32x4*)(rowA + 8192 + 512 * c); } else { va[c] = (u32x4){zz, zz, zz, zz}; vb[c] = va[c]; } }
        sel_row(va, hist, hist2, bm, b, q0, qlA, wid, lane, zz);
        sel_row(vb, hist, hist2, bm, b, q0, qlA + 1, wid, lane, zz);
    }
    __syncthreads();
}

__device__ __forceinline__ void dsa_kv_item(unsigned char* lds, const bf16_t* proj, const float* nw, const bf16_t* wkv, bf16_t* Kd, bf16_t* VT, int item, int lane, int wid) {
    bf16_t* cb = (bf16_t*)lds;
    const int tok0 = item * 64, b = tok0 / S, r32 = lane & 31, hi = lane >> 5;
    {
        unsigned pv[8]; float ss[8];
#pragma unroll
        for (int rr = 0; rr < 8; ++rr) pv[rr] = *(const unsigned*)(PJ(proj, tok0 + 8 * wid + rr, C_CKV + 2 * lane));
        const float n0 = nw[2 * lane], n1 = nw[2 * lane + 1];
#pragma unroll
        for (int rr = 0; rr < 8; ++rr) { const float f0 = __uint_as_float(pv[rr] << 16), f1 = __uint_as_float(pv[rr] & 0xffff0000u); ss[rr] = f0 * f0 + f1 * f1; }
#pragma unroll
        for (int o = 1; o < 64; o <<= 1) {
#pragma unroll
            for (int rr = 0; rr < 8; ++rr) ss[rr] += __shfl_xor(ss[rr], o); }
#pragma unroll
        for (int rr = 0; rr < 8; ++rr) { const float f0 = __uint_as_float(pv[rr] << 16), f1 = __uint_as_float(pv[rr] & 0xffff0000u); const float rstd = rsqrtf(ss[rr] * (1.f / 128.f) + NORM_EPS);
            *(unsigned*)(cb + (8 * wid + rr) * 136 + 2 * lane) = cvtpk(f0 * rstd * n0, f1 * rstd * n1); }
    }
    __syncthreads();
    bf16x8 Wa[8], Wb[8];
#define DKV_LOADW(W_, tile_) do { const int id_ = (tile_) & 15, nt_ = id_ >> 1; const bf16_t* wp_ = wkv + (size_t)((((tile_) >= 16) ? 256 : 0) + 32 * nt_ + r32) * 128 + 8 * hi; \
        _Pragma("unroll") for (int ks = 0; ks < 8; ++ks) W_[ks] = *(const bf16x8*)(wp_ + 16 * ks); } while (0)
#define DKV_TILE(W_, tile_) do { const int id = (tile_) & 15, tt = id & 1, nt = id >> 1; const bool isv = (tile_) >= 16; \
        const bf16_t* ap = cb + (32 * tt + r32) * 136 + 8 * hi; f32x16 acc = {}; \
        _Pragma("unroll") for (int ks = 0; ks < 8; ++ks) { const bf16x8 a = *(const bf16x8*)(ap + 16 * ks); acc = isv ? MFMA32(W_[ks], a, acc) : MFMA32(a, W_[ks], acc); } \
        if (!isv) { \
            _Pragma("unroll") for (int r = 0; r < 16; ++r) { const int d = (32 * nt + r32) & 63, kk = crow(r, hi); \
                Kd[((size_t)(b * 4 + (nt >> 1)) * 256 + (((tok0 - b * S) >> 5) + tt)) * 2048 + ((((d >> 4) * 2 + ((d >> 3) & 1)) * 32 + kk) * 8 + (d & 7))] = (bf16_t)f2bf(acc[r]); } \
        } else { \
            _Pragma("unroll") for (int r = 0; r < 16; ++r) { const int n = 32 * nt + crow(r, hi); const int d = n & 63, k16 = r32 & 15; \
                VT[((size_t)(b * 4 + (n >> 6)) * 256 + (((tok0 - b * S) >> 5) + tt)) * 2048 + ((((((d >> 5) * 2 + (r32 >> 4)) * 2 + ((k16 >> 2) & 1)) * 32 + (d & 31)) * 8) + (k16 & 3) + 4 * (k16 >> 3))] = (bf16_t)f2bf(acc[r]); } \
        } } while (0)
    DKV_LOADW(Wa, wid);
    DKV_LOADW(Wb, wid + 8); DKV_TILE(Wa, wid);
    DKV_LOADW(Wa, wid + 16); DKV_TILE(Wb, wid + 8);
    DKV_LOADW(Wb, wid + 24); DKV_TILE(Wa, wid + 16);
    DKV_TILE(Wb, wid + 24);
#undef DKV_LOADW
#undef DKV_TILE
    __syncthreads();
}

template <int MODE>
__device__ __forceinline__ void dsa_att_wave(const bf16_t* proj, const bf16_t* KH, const bf16_t* VTT, const unsigned* bm32, bf16_t* mixed, int b, int h, int q0, int kt0, int kt1, LASP float* pbuf, int lane) {
    const int r32 = lane & 31, hi = lane >> 5;
    const bf16_t* qp = PJ(proj, b * S + q0 + r32, C_DQ + h * 64) + 8 * hi;
    bf16x8 Qf[4];
#pragma unroll
    for (int ks = 0; ks < 4; ++ks) Qf[ks] = *(const bf16x8*)(qp + 16 * ks);
    const bf16_t* kbase = KH + (size_t)(b * 4 + h) * 256 * 2048 + (hi * 32 + r32) * 8;
    const bf16_t* vbase = VTT + (size_t)(b * 4 + h) * 256 * 2048 + (hi * 32 + r32) * 8;
    const unsigned* mrow = bm32 + (size_t)(b * 256 + (q0 >> 5)) * 256 * 32 + r32;
    constexpr float C2 = 0.125f * 1.4426950408889634f, DEFER_RAW = 6.f / C2;
    f32x16 o0 = {}, o1 = {}; float m = -1e30f, l = 0.f;
    bf16x8 Ka[4], Kb[4], Va[4], Vb[4]; unsigned Wa, Wb; f32x16 sa, sb, lacc = {};
    const bf16x8 ONES = {(short)0x3f80, (short)0x3f80, (short)0x3f80, (short)0x3f80, (short)0x3f80, (short)0x3f80, (short)0x3f80, (short)0x3f80};
#define DSA_LOADK(K_, kt_) do { const bf16_t* kp_ = kbase + (size_t)(kt_) * 2048; _Pragma("unroll") for (int ks = 0; ks < 4; ++ks) K_[ks] = *(const bf16x8*)(kp_ + 512 * ks); } while (0)
#define DSA_LOADV(V_, W_, kt_) do { const bf16_t* vp_ = vbase + (size_t)(kt_) * 2048; V_[0] = *(const bf16x8*)(vp_); V_[1] = *(const bf16x8*)(vp_ + 512); V_[2] = *(const bf16x8*)(vp_ + 1024); V_[3] = *(const bf16x8*)(vp_ + 1536); W_ = mrow[(kt_) * 32]; } while (0)
#define DSA_QK(s_, K_) do { s_ = (f32x16){}; _Pragma("unroll") for (int ks = 0; ks < 4; ++ks) s_ = MFMA32(K_[ks], Qf[ks], s_); } while (0)
#define DSA_SMPV(s_, V_, W_) do { \
        float tmax = fmx(fmx(s_[0], s_[1]), fmx(s_[2], s_[3])); \
        _Pragma("unroll") for (int r = 4; r < 16; r += 4) tmax = fmx(tmax, fmx(fmx(s_[r], s_[r + 1]), fmx(s_[r + 2], s_[r + 3]))); \
        tmax = xhalf_max(tmax); \
        if (__any(tmax > m + DEFER_RAW)) { const float mn = fmx(m, tmax), alpha = __builtin_amdgcn_exp2f((m - mn) * C2); o0 = o0 * alpha; o1 = o1 * alpha; lacc[0] *= alpha; m = mn; }     \
        const float mc = m * C2; const int Ws = (int)((W_) >> (4 * hi)); float p[16]; float psum = 0.f; \
        _Pragma("unroll") for (int r = 0; r < 16; ++r) { const float e = __builtin_amdgcn_exp2f(fmaf(s_[r], C2, -mc)); int mk = __builtin_amdgcn_sbfe(Ws, (r & 3) + 8 * (r >> 2), 1); \
            asm volatile("" : "+v"(mk));     \
            p[r] = __uint_as_float(__float_as_uint(e) & (unsigned)mk); } \
        (void)psum; const bf16x8 P0 = pack8h(p), P1 = pack8h(p + 8); \
        o0 = MFMA32(V_[0], P0, o0); o1 = MFMA32(V_[2], P0, o1); o0 = MFMA32(V_[1], P1, o0); o1 = MFMA32(V_[3], P1, o1); \
        lacc = MFMA32(ONES, P0, lacc); lacc = MFMA32(ONES, P1, lacc); } while (0)
    if (kt0 < kt1) {
        const int lastt = kt1 - 1;
#define DSA_CL(k_) ((k_) < kt1 ? (k_) : lastt)
        DSA_LOADK(Ka, kt0); DSA_LOADV(Va, Wa, kt0); DSA_LOADK(Kb, DSA_CL(kt0 + 1));
        DSA_QK(sa, Ka);
        for (int kt = kt0; kt < kt1; kt += 2) {
            DSA_LOADK(Ka, DSA_CL(kt + 2)); DSA_LOADV(Vb, Wb, DSA_CL(kt + 1));
            DSA_QK(sb, Kb);
            DSA_SMPV(sa, Va, Wa);
            if (kt + 1 < kt1) {
                DSA_LOADK(Kb, DSA_CL(kt + 3)); DSA_LOADV(Va, Wa, DSA_CL(kt + 2));
                DSA_QK(sa, Ka);
                DSA_SMPV(sb, Vb, Wb);
            }
        }
#undef DSA_CL
    }
#undef DSA_LOADK
#undef DSA_LOADV
#undef DSA_QK
#undef DSA_SMPV
    l = 0.5f * lacc[0];

    if (MODE == 1) {
#pragma unroll
        for (int r = 0; r < 16; ++r) { pbuf[r * 64 + lane] = o0[r]; pbuf[(16 + r) * 64 + lane] = o1[r]; }
        pbuf[32 * 64 + lane] = m; pbuf[33 * 64 + lane] = l;
    }
    if (MODE != 0) __syncthreads();
    if (MODE == 1) return;
    if (MODE == 2) {
        const float mb = pbuf[32 * 64 + lane], lb = pbuf[33 * 64 + lane];
        const float mn = fmx(m, mb), fa = __builtin_amdgcn_exp2f((m - mn) * C2), fb = __builtin_amdgcn_exp2f((mb - mn) * C2);
        l = l * fa + lb * fb;
#pragma unroll
        for (int r = 0; r < 16; ++r) { o0[r] = o0[r] * fa + pbuf[r * 64 + lane] * fb; o1[r] = o1[r] * fa + pbuf[(16 + r) * 64 + lane] * fb; }
    }
    l = xhalf_sum(l);
    const float inv = 1.f / l;
    bf16_t* orow = mixed + (size_t)(b * S + q0 + r32) * DM + 256 + h * 64 + 4 * hi;
#pragma unroll
    for (int g = 0; g < 4; ++g) { u32x2 a, c; a.x = cvtpk(o0[4 * g] * inv, o0[4 * g + 1] * inv); a.y = cvtpk(o0[4 * g + 2] * inv, o0[4 * g + 3] * inv);
        c.x = cvtpk(o1[4 * g] * inv, o1[4 * g + 1] * inv); c.y = cvtpk(o1[4 * g + 2] * inv, o1[4 * g + 3] * inv);
        *(u32x2*)(orow + 8 * g) = a; *(u32x2*)(orow + 32 + 8 * g) = c; }
}

__device__ __forceinline__ void rot8(int pos, int i0, float* c, float* s) {
#pragma unroll
    for (int e = 0; e < 8; ++e) { const float inv = __builtin_amdgcn_exp2f(-(float)(i0 + e) * (13.287712379549449f / 32.f));
        float t = ((float)pos * inv) * 0.15915494309189535f; t = t - floorf(t); s[e] = __builtin_amdgcn_sinf(t); c[e] = __builtin_amdgcn_cosf(t); }
}
__device__ __forceinline__ void ret_kv_item(unsigned char* lds_g, const bf16_t* proj, float* KVT, int item, int tid) {
    LASP unsigned char* lds = (LASP unsigned char*)lds_g;
    const int b = item >> 8, h = (item >> 6) & 3, n = item & 63, tok0 = b * S + n * 128;
    const int lane = tid & 63, wid = __builtin_amdgcn_readfirstlane(tid >> 6), r32 = lane & 31, hi = lane >> 5;
    LASP unsigned char* Kimg = lds; LASP unsigned char* Vimg = lds + 16384;
    const float lg = log2_gamma(h);
    {
        const int j = tid >> 2, c4 = tid & 3; const bf16_t* p = PJ(proj, tok0 + j, C_RK + h * 64);
        const bf16x8 a = *(const bf16x8*)(p + 8 * c4), bb = *(const bf16x8*)(p + 32 + 8 * c4);
        float cs[8], sn[8]; rot8(n * 128 + j, 8 * c4, cs, sn);
        const float z = 0.125f * __builtin_amdgcn_exp2f((float)(127 - j) * lg);
        float y1[8], y2[8];
#pragma unroll
        for (int e = 0; e < 8; ++e) { const float x1 = bf2f((bf16_t)a[e]), x2 = bf2f((bf16_t)bb[e]); y1[e] = (x1 * cs[e] - x2 * sn[e]) * z; y2[e] = (x2 * cs[e] + x1 * sn[e]) * z; }
        LASP unsigned char* dst = Kimg + (j >> 5) * 4096 + (j & 31) * 64 + c4 * 16;
        *(LASP bf16x8*)(dst) = pack8h(y1); *(LASP bf16x8*)(dst + 2048) = pack8h(y2);
    }
#pragma unroll
    for (int it = 0; it < 2; ++it) { const int idx = tid + 512 * it, j = idx >> 3, c8 = idx & 7;
        const bf16x8 v = *(const bf16x8*)(PJ(proj, tok0 + j, C_RV + h * 64) + 8 * c8);
        *(LASP bf16x8*)(Vimg + (j >> 5) * 4096 + (c8 >> 2) * 2048 + (j & 31) * 64 + (c8 & 3) * 16) = v; }
    __syncthreads();
    if (wid < 4) {
        const int et = wid >> 1, dt = wid & 1;
        const int vrd = (4 * hi + ((lane & 15) >> 2)) * 64 + (16 * ((lane >> 4) & 1) + 4 * (lane & 3)) * 2;
        f32x16 acc = {};
#pragma unroll
        for (int st = 0; st < 4; ++st)
#pragma unroll
            for (int t = 0; t < 2; ++t) {
                LASP const unsigned char* va = Vimg + st * 4096 + et * 2048 + vrd + t * 1024; LASP const unsigned char* ka = Kimg + st * 4096 + dt * 2048 + vrd + t * 1024;
                const u32x2 a0 = ldtr(va), a1 = ldtr(va + 512), b0 = ldtr(ka), b1 = ldtr(ka + 512);
                acc = MFMA32(join8(a0, a1), join8(b0, b1), acc);
            }
        float* o = KVT + (size_t)item * 4096 + 32 * dt + r32;
#pragma unroll
        for (int r = 0; r < 16; ++r) o[(32 * et + crow(r, hi)) * 64] = acc[r];
    }
    __syncthreads();
}
__device__ __forceinline__ void ret_out_item(unsigned char* lds_g, const bf16_t* proj, const float* KVT, const float* rnw, bf16_t* mixed, int item, int tid, int lane, int wid) {
    LASP unsigned char* lds = (LASP unsigned char*)lds_g;
    const int b = item >> 8, h = (item >> 6) & 3, n = item & 63, tok0 = b * S + n * 128, r32 = lane & 31, hi = lane >> 5;
    LASP bf16_t* Qb = (LASP bf16_t*)lds; LASP bf16_t* Kb = Qb + 128 * 72; LASP unsigned char* Vimg = (LASP unsigned char*)(Kb + 128 * 72); LASP bf16_t* St = (LASP bf16_t*)(Vimg + 16384);
    const float lg = log2_gamma(h);
    {
        const int j = tid >> 2, c4 = tid & 3;
        const bf16_t* pq = PJ(proj, tok0 + j, C_RQ + h * 64); const bf16_t* pk = PJ(proj, tok0 + j, C_RK + h * 64);
        const bf16x8 qa = *(const bf16x8*)(pq + 8 * c4), qb = *(const bf16x8*)(pq + 32 + 8 * c4), ka = *(const bf16x8*)(pk + 8 * c4), kb = *(const bf16x8*)(pk + 32 + 8 * c4);
        const int j0 = tid >> 3, j1 = (tid + 512) >> 3, c8 = tid & 7;
        const bf16x8 v0 = *(const bf16x8*)(PJ(proj, tok0 + j0, C_RV + h * 64) + 8 * c8), v1 = *(const bf16x8*)(PJ(proj, tok0 + j1, C_RV + h * 64) + 8 * c8);
        float cs[8], sn[8]; rot8(n * 128 + j, 8 * c4, cs, sn);
        float y1[8], y2[8];
#pragma unroll
        for (int e = 0; e < 8; ++e) { const float x1 = bf2f((bf16_t)qa[e]), x2 = bf2f((bf16_t)qb[e]); y1[e] = x1 * cs[e] - x2 * sn[e]; y2[e] = x2 * cs[e] + x1 * sn[e]; }
        *(LASP bf16x8*)(Qb + j * 72 + 8 * c4) = pack8h(y1); *(LASP bf16x8*)(Qb + j * 72 + 32 + 8 * c4) = pack8h(y2);
#pragma unroll
        for (int e = 0; e < 8; ++e) { const float x1 = bf2f((bf16_t)ka[e]), x2 = bf2f((bf16_t)kb[e]); y1[e] = (x1 * cs[e] - x2 * sn[e]) * 0.125f; y2[e] = (x2 * cs[e] + x1 * sn[e]) * 0.125f; }
        *(LASP bf16x8*)(Kb + j * 72 + 8 * c4) = pack8h(y1); *(LASP bf16x8*)(Kb + j * 72 + 32 + 8 * c4) = pack8h(y2);
        *(LASP bf16x8*)(Vimg + (j0 >> 5) * 4096 + (c8 >> 2) * 2048 + (j0 & 31) * 64 + (c8 & 3) * 16) = v0;
        *(LASP bf16x8*)(Vimg + (j1 >> 5) * 4096 + (c8 >> 2) * 2048 + (j1 & 31) * 64 + (c8 & 3) * 16) = v1;
    }
    {
        const float g = exp2f(128.f * lg); float w = 1.f; f32x4 a0 = {0.f, 0.f, 0.f, 0.f}, a1 = {0.f, 0.f, 0.f, 0.f};
        const float* kp = KVT + (size_t)(item - n) * 4096 + 8 * tid;
        for (int mm = n - 1; mm >= 0; mm -= 8) {
            f32x4 u[8][2];
#pragma unroll
            for (int i = 0; i < 8; ++i) { const int mi = (mm - i) >= 0 ? (mm - i) : 0; u[i][0] = *(const f32x4*)(kp + (size_t)mi * 4096); u[i][1] = *(const f32x4*)(kp + (size_t)mi * 4096 + 4); }
#pragma unroll
            for (int i = 0; i < 8; ++i) { const float wi = (mm - i) >= 0 ? w : 0.f; a0 += u[i][0] * wi; a1 += u[i][1] * wi; w *= g; }
        }
        const int e = (8 * tid) >> 6, d0 = (8 * tid) & 63;
        u32x4 o; o.x = cvtpk(a0.x, a0.y); o.y = cvtpk(a0.z, a0.w); o.z = cvtpk(a1.x, a1.y); o.w = cvtpk(a1.z, a1.w);
        *(LASP u32x4*)(St + e * 72 + d0) = o;
    }
    __syncthreads();
    if (wid < 4) {
        const int cs = wid, c = 32 * cs + r32;
        const int vrd = (4 * hi + ((lane & 15) >> 2)) * 64 + (16 * ((lane >> 4) & 1) + 4 * (lane & 3)) * 2;
        bf16x8 Qf[4];
#pragma unroll
        for (int ks = 0; ks < 4; ++ks) Qf[ks] = *(LASP const bf16x8*)(Qb + (32 * cs + r32) * 72 + 16 * ks + 8 * hi);
        f32x16 x0 = {}, x1 = {}, o0 = {}, o1 = {};
#pragma unroll
        for (int ks = 0; ks < 4; ++ks) { x0 = MFMA32(*(LASP const bf16x8*)(St + (r32) * 72 + 16 * ks + 8 * hi), Qf[ks], x0); x1 = MFMA32(*(LASP const bf16x8*)(St + (32 + r32) * 72 + 16 * ks + 8 * hi), Qf[ks], x1); }
        for (int ms = 0; ms <= cs; ++ms) {
            f32x16 s = {};
#pragma unroll
            for (int ks = 0; ks < 4; ++ks) s = MFMA32(*(LASP const bf16x8*)(Kb + (32 * ms + r32) * 72 + 16 * ks + 8 * hi), Qf[ks], s);
            float p[16];
#pragma unroll
            for (int r = 0; r < 16; ++r) { const int dlt = c - (32 * ms + crow(r, hi)); p[r] = (dlt >= 0) ? s[r] * __builtin_amdgcn_exp2f((float)dlt * lg) : 0.f; }
            const bf16x8 P0 = pack8h(p), P1 = pack8h(p + 8);
            LASP const unsigned char* vt = Vimg + ms * 4096 + vrd;
            const u32x2 a00 = ldtr(vt), a01 = ldtr(vt + 512), a10 = ldtr(vt + 1024), a11 = ldtr(vt + 1536);
            const u32x2 b00 = ldtr(vt + 2048), b01 = ldtr(vt + 2048 + 512), b10 = ldtr(vt + 2048 + 1024), b11 = ldtr(vt + 2048 + 1536);
            o0 = MFMA32(join8(a00, a01), P0, o0); o0 = MFMA32(join8(a10, a11), P1, o0);
            o1 = MFMA32(join8(b00, b01), P0, o1); o1 = MFMA32(join8(b10, b11), P1, o1);
        }
        const float xi = __builtin_amdgcn_exp2f((float)(c + 1) * lg);
        o0 = o0 + x0 * xi; o1 = o1 + x1 * xi;
        float sm = 0.f;
#pragma unroll
        for (int r = 0; r < 16; ++r) sm += o0[r] + o1[r];
        sm = xhalf_sum(sm); const float mean = sm * (1.f / 64.f);
        float vs = 0.f;
#pragma unroll
        for (int r = 0; r < 16; ++r) { const float d0 = o0[r] - mean, d1 = o1[r] - mean; vs += d0 * d0 + d1 * d1; }
        vs = xhalf_sum(vs); const float rstd = rsqrtf(vs * (1.f / 64.f) + NORM_EPS);
        const bf16_t* gp = PJ(proj, tok0 + c, C_RG + h * 64) + 4 * hi; bf16_t* orow = mixed + (size_t)(tok0 + c) * DM + h * 64 + 4 * hi; const float* wn = rnw + h * 64 + 4 * hi;
#pragma unroll
        for (int g = 0; g < 4; ++g) {
#pragma unroll
            for (int dt = 0; dt < 2; ++dt) { const u32x2 gg = *(const u32x2*)(gp + 32 * dt + 8 * g); const f32x4 ww = *(const f32x4*)(wn + 32 * dt + 8 * g);
                const float gv[4] = {__uint_as_float(gg.x << 16), __uint_as_float(gg.x & 0xffff0000u), __uint_as_float(gg.y << 16), __uint_as_float(gg.y & 0xffff0000u)};
                const float wv[4] = {ww.x, ww.y, ww.z, ww.w}; float y[4];
#pragma unroll
                for (int e = 0; e < 4; ++e) { const float ov = dt ? o1[4 * g + e] : o0[4 * g + e]; const float yy = (ov - mean) * rstd * wv[e]; y[e] = yy * gv[e] / (1.f + __expf(-gv[e])); }
                u32x2 ow; ow.x = cvtpk(y[0], y[1]); ow.y = cvtpk(y[2], y[3]); *(u32x2*)(orow + 32 * dt + 8 * g) = ow; } }
    }
    __syncthreads();
}
__device__ __forceinline__ void zero_cols(bf16_t* mixed, int col0, int ncols, int gtid, int gthreads) {
    const int per = ncols / 8; const size_t tot = (size_t)M * per;
    for (size_t i = gtid; i < tot; i += gthreads) { const size_t row = i / per; const int c = (int)(i % per); *(u32x4*)(mixed + row * DM + col0 + 8 * c) = (u32x4){0u, 0u, 0u, 0u}; }
}

#define GAS __attribute__((address_space(1)))
#define LAS __attribute__((address_space(3)))
typedef GAS unsigned gu32;
typedef GAS unsigned long long gu64;
#define RLX_AGENT __ATOMIC_RELAXED, __HIP_MEMORY_SCOPE_AGENT
#define LDS_WAIT() asm volatile("s_waitcnt lgkmcnt(0)" ::: "memory")
#define VM_WAIT() asm volatile("s_waitcnt vmcnt(0)" ::: "memory")

#define XB_TMO      128
#define XB_XCNT(j)  (256  + 64 * (j))
#define XB_XSUB(j)  (1280 + 64 * (j))
#define XB_XGEN(j)  (2304 + 64 * (j))
#define XB_TOP      3328
#define XB_TOPGEN   3392
#define XCD_BAR_WORDS 3456
#define XB_SPIN_CAP (1u << 18)

__device__ __forceinline__ unsigned xb_ld(unsigned* p)              { return __hip_atomic_load(p, __ATOMIC_RELAXED, __HIP_MEMORY_SCOPE_AGENT); }
__device__ __forceinline__ unsigned xb_add(unsigned* p, unsigned v) { return __hip_atomic_fetch_add(p, v, __ATOMIC_RELAXED, __HIP_MEMORY_SCOPE_AGENT); }
__device__ __forceinline__ unsigned xb_xcc_id() { return (unsigned)__builtin_amdgcn_s_getreg((3 << 11) | 20) & 0xFu; }
#define XB_SPIN(cond, bar) do { unsigned _sp = 0; while (cond) { __builtin_amdgcn_s_sleep(1); \
    if ((++_sp & 255u) == 0u) { if (xb_ld(&(bar)[XB_TMO])) break; if (_sp > XB_SPIN_CAP) { atomicAdd(&(bar)[XB_TMO], 1u); break; } } } } while (0)

struct XcdBarrier {
    unsigned* bar; unsigned x;
    volatile LAS unsigned* st;
};

__device__ __forceinline__ XcdBarrier xcd_barrier_post(unsigned* bar, volatile LAS unsigned* st) {
    XcdBarrier b; b.bar = bar; b.x = xb_xcc_id(); b.st = st;
    if (threadIdx.x == 0) (void)xb_add(&bar[XB_XCNT(b.x)], 1u);
    return b;
}
__device__ __forceinline__ void xcd_barrier_complete(unsigned* bar, unsigned x, unsigned& nloc, unsigned& nx) {
    const unsigned G = gridDim.x * gridDim.y * gridDim.z;
    unsigned sum, cnt, mine, sp = 0u;
    for (;;) {
        sum = 0u; cnt = 0u; mine = 0u;
#pragma unroll
        for (unsigned j = 0; j < 16; ++j) { const unsigned c = xb_ld(&bar[XB_XCNT(j)]); sum += c; cnt += (c > 0u) ? 1u : 0u; mine = (j == x) ? c : mine; }
        if (sum == G) break;
        __builtin_amdgcn_s_sleep(1);
        if ((++sp & 255u) == 0u) { if (xb_ld(&bar[XB_TMO])) break; if (sp > XB_SPIN_CAP) { atomicAdd(&bar[XB_TMO], 1u); break; } }
    }
    nloc = mine > 0u ? mine : 1u; nx = cnt > 0u ? cnt : 1u;
}

__device__ __forceinline__ void xcd_barrier(const XcdBarrier& b) {
    asm volatile("s_waitcnt vmcnt(0)" ::: "memory");
    __syncthreads();
    if (threadIdx.x == 0) {
        unsigned* bar = b.bar;
        __builtin_amdgcn_s_waitcnt(0);
        unsigned nloc = b.st[0], nx = b.st[1];
        if (nloc == 0u) { xcd_barrier_complete(bar, b.x, nloc, nx); b.st[0] = nloc; b.st[1] = nx; }
        const unsigned old = xb_add(&bar[XB_XSUB(b.x)], 1u);
        const unsigned gen = old / nloc;
        if (old + 1u == (gen + 1u) * nloc) {
            __builtin_amdgcn_fence(__ATOMIC_RELEASE, "agent");
            asm volatile("s_waitcnt vmcnt(0)" ::: "memory");
            const unsigned og = xb_add(&bar[XB_TOP], 1u);
            const unsigned tg = og / nx;
            if (og + 1u == (tg + 1u) * nx) xb_add(&bar[XB_TOPGEN], 1u);
            else XB_SPIN(xb_ld(&bar[XB_TOPGEN]) == tg, bar);
            __builtin_amdgcn_fence(__ATOMIC_ACQUIRE, "agent");
            xb_add(&bar[XB_XGEN(b.x)], 1u);
            asm volatile("s_waitcnt vmcnt(0)" ::: "memory");
        } else {
            XB_SPIN(xb_ld(&bar[XB_XGEN(b.x)]) == gen, bar);
            __builtin_amdgcn_fence(__ATOMIC_ACQUIRE, "agent");
            asm volatile("s_waitcnt vmcnt(0)" ::: "memory");
        }
    }
    __syncthreads();
}


__device__ __forceinline__ void team_barrier(unsigned* ctr, unsigned* bar, volatile LAS unsigned* same_xcd) {
    asm volatile("s_waitcnt vmcnt(0)" ::: "memory");
    __syncthreads();
    if (threadIdx.x == 0) {
        __builtin_amdgcn_s_waitcnt(0);
        if (*same_xcd == 0u) {
            __builtin_amdgcn_fence(__ATOMIC_RELEASE, "agent");
            asm volatile("s_waitcnt vmcnt(0)" ::: "memory"); }
        (void)xb_add(ctr, 1u);
        XB_SPIN(xb_ld(ctr) < 4u, bar);
        __builtin_amdgcn_fence(__ATOMIC_ACQUIRE, "agent");
        asm volatile("s_waitcnt vmcnt(0)" ::: "memory");
    }
    __syncthreads();
}
constexpr size_t WS_XTAB = 900 * 1024;
constexpr size_t WS_TEAM = 768 * 1024;

struct Params { const float* in[12]; float* out; unsigned char* ws; };
__global__ void __launch_bounds__(512, 2) hymba_fwd(Params p) {
    extern __shared__ __attribute__((aligned(16))) unsigned char lds[];
    cg::grid_group grid = cg::this_grid();
    for (int u = threadIdx.x; u < (LDS_BYTES - 131072) / 4; u += 512) ((__attribute__((address_space(3))) unsigned*)((__attribute__((address_space(3))) unsigned char*)lds + 131072))[u] = 0u;
    __syncthreads();
    const XcdBarrier xbar = xcd_barrier_post((unsigned*)p.ws, (volatile __attribute__((address_space(3))) unsigned*)((__attribute__((address_space(3))) unsigned char*)lds + 131072 + 320) + 8);
#define GSYNC() xcd_barrier(xbar)
    if (threadIdx.x == 0) __hip_atomic_store((unsigned*)(p.ws + WS_XTAB) + blockIdx.x, xbar.x + 1u, __ATOMIC_RELAXED, __HIP_MEMORY_SCOPE_AGENT);
#define TEAM_SYNC(seam) do { if (gridDim.x == 256) { int b_ = blockIdx.x; asm volatile("" : "+s"(b_)); team_barrier((unsigned*)(p.ws + WS_TEAM) + ((layer * 2 + (seam)) * 64 + 8 * (b_ & 7) + ((b_ >> 3) & 7)) * 64, (unsigned*)p.ws, xbar.st + 2); } else GSYNC(); } while (0)
#define PHASE_VARS() int tid = threadIdx.x; asm volatile("" : "+v"(tid)); int bid = blockIdx.x, G = gridDim.x; asm volatile("" : "+s"(bid), "+s"(G)); \
    const int lane = tid & 63, wid = __builtin_amdgcn_readfirstlane(tid >> 6), gw = bid * 8 + wid, NGW = G * 8; (void)lane; (void)wid; (void)gw; (void)NGW; \
    __attribute__((address_space(1))) unsigned char* ws = (__attribute__((address_space(1))) unsigned char*)p.ws; asm volatile("" : "+s"(ws));     \
    __attribute__((address_space(3))) unsigned char* gl = (__attribute__((address_space(3))) unsigned char*)lds; (void)gl; \
    float* tscr = (float*)(lds + wid * 16384); (void)tscr;
#define WSP(T, off) ((T*)(ws + (off)))
#define SSQ(i) (WSP(float, WS_SSQ) + (size_t)(i) * M)
    {
        PHASE_VARS();
        {
#define LAYER_ 0
                const float* w_in = p.in[2] + (size_t)LAYER_ * DM * NIN; const float* w_out = p.in[7] + (size_t)LAYER_ * DM * DM;
                const float* w_uk = p.in[5] + (size_t)LAYER_ * 128 * 256; const float* w_uv = p.in[6] + (size_t)LAYER_ * 128 * 256;
                constexpr int I_IN = 16 * 112, I_OUT = 16 * 32, I_KV = 2 * 8;
                for (int it = gw; it < I_IN + I_OUT + 2 * I_KV; it += NGW) {
                    int r = it;
                    if (r < I_IN) { transpose_item<1, true>(w_in, DM, NIN, WSP(bf16_t, WS_WIN), 112, tscr, r, lane, p.in[1] + LAYER_ * DM); continue; } r -= I_IN;
                    if (r < I_OUT) { transpose_item<0, false>(w_out, DM, DM, WSP(bf16_t, WS_WOUT), 32, tscr, r, lane); continue; } r -= I_OUT;
                    if (r < I_KV) { transpose_item<0, false>(w_uk, 128, 256, WSP(bf16_t, WS_WKV), 8, tscr, r, lane); continue; } r -= I_KV;
                    transpose_item<0, false>(w_uv, 128, 256, WSP(bf16_t, WS_WKV) + 256 * 128, 8, tscr, r, lane);
                }
#undef LAYER_
        }
        for (int m = gw; m < M; m += NGW) row_xb_ssq(p.in[0] + (size_t)m * DM, WSP(bf16_t, WS_XB) + (size_t)m * DM, SSQ(0) + m, lane);
    }
    GSYNC();
    if (threadIdx.x == 0 && gridDim.x == 256) {
        const unsigned* xt = (const unsigned*)(p.ws + WS_XTAB) + (blockIdx.x & 63); const unsigned x0 = xb_ld((unsigned*)xt);
        xbar.st[2] = (x0 != 0u && xb_ld((unsigned*)xt + 64) == x0 && xb_ld((unsigned*)xt + 128) == x0 && xb_ld((unsigned*)xt + 192) == x0) ? 1u : 0u; }
    if (p.ws == nullptr) grid.sync();
#pragma nounroll
    for (int layer = 0; layer < DEPTH; ++layer) {
        for (int rep_ = 0; rep_ < REP_GIN; ++rep_) {
        {
            PHASE_VARS();
            pg8::Gemm g{WSP(bf16_t, WS_XB), WSP(bf16_t, WINB(layer)), M, NP, DM}; pg8::StaticOrder So; So.init(M, NP, G, bid);
            pg8::EpiBf16<0> E{WSP(bf16_t, WS_PROJ), 64, M, C_KI >> 6, C_LQ >> 6, SSQ(2 * layer)};
            pg8::gemm_phase<pg8::EpiBf16<0>, pg8::StaticOrder, true, true>(gl, g, So, E);
            if (rep_ + 1 == REP_GIN) {
                const int maxu = (896 + G - 1) / G, nidle = G * maxu - 896, first = nidle ? G - nidle : 0;
                if (bid >= first) {
                    const float* w_up = p.in[9] + (size_t)layer * DM * DFF; const float* w_dn = p.in[10] + (size_t)layer * DFF * DM;
                    constexpr int I_UP = 16 * 128, I_DN = 64 * 32;
                    for (int it = (bid - first) * 8 + wid; it < I_UP + I_DN; it += (G - first) * 8) {
                        if (it < I_UP) transpose_item<0, true>(w_up, DM, DFF, WSP(bf16_t, WS_WUP), 128, tscr, it, lane, p.in[8] + layer * DM);
                        else transpose_item<0, false>(w_dn, DFF, DM, WSP(bf16_t, WS_WDN), 32, tscr, it - I_UP, lane);
                    }
                    if (layer + 1 < DEPTH) {
#define LAYER_ (layer + 1)
                        const float* w_in = p.in[2] + (size_t)LAYER_ * DM * NIN; const float* w_out = p.in[7] + (size_t)LAYER_ * DM * DM;
                        const float* w_uk = p.in[5] + (size_t)LAYER_ * 128 * 256; const float* w_uv = p.in[6] + (size_t)LAYER_ * 128 * 256;
                        constexpr int I_IN = 16 * 112, I_OUT = 16 * 32, I_KV = 2 * 8;
                        for (int it = (bid - first) * 8 + wid; it < I_IN + I_OUT + 2 * I_KV; it += (G - first) * 8) {
                            int r = it;
                            if (r < I_IN) { transpose_item<1, true>(w_in, DM, NIN, WSP(bf16_t, WINB(LAYER_)), 112, tscr, r, lane, p.in[1] + LAYER_ * DM); continue; } r -= I_IN;
                            if (r < I_OUT) { transpose_item<0, false>(w_out, DM, DM, WSP(bf16_t, WOUTB(LAYER_)), 32, tscr, r, lane); continue; } r -= I_OUT;
                            if (r < I_KV) { transpose_item<0, false>(w_uk, 128, 256, WSP(bf16_t, WKVB(LAYER_)), 8, tscr, r, lane); continue; } r -= I_KV;
                            transpose_item<0, false>(w_uv, 128, 256, WSP(bf16_t, WKVB(LAYER_)) + 256 * 128, 8, tscr, r, lane);
                        }
#undef LAYER_
                    }
                }
            }
        }
        if (rep_ + 1 < REP_GIN) GSYNC();
        }
        GSYNC();
        for (int rep_ = 0; rep_ < REP_MIXA; ++rep_) {
        {
            PHASE_VARS();
#if EN_DIL
            for (int rp_ = 0; rp_ < RP_DIL; ++rp_) for (int it = bid; it < 256; it += G) {
                const int bh = (it & 7) + 8 * ((it >> 7) & 1), blk = (it >> 3) & 15;
                dil_item(lds, WSP(bf16_t, WS_PROJ), WSP(bf16_t, WS_MIXED), bh * 16 + blk, tid, lane, wid); }
#else
            zero_cols(WSP(bf16_t, WS_MIXED), 512, 512, bid * 512 + tid, G * 512);
#endif
#if EN_DSA
            for (int rp_ = 0; rp_ < RP_IDX; ++rp_) for (int it = bid; it < 1024; it += G) {
                const int n4 = it >> 8, c8 = it & 255; const int b = n4 >> 1, qt = (n4 & 1) ? (511 - c8) : c8;
                idx_item(lds, WSP(bf16_t, WS_PROJ), (bf16_t*)((unsigned char*)p.out + (size_t)bid * SCR_PER_WG), WSP(unsigned char, WS_BM), b, qt, tid, lane, wid);
            }
            for (int rp_ = 0; rp_ < RP_DKV; ++rp_) for (int it = bid; it < 256; it += G) dsa_kv_item(lds, WSP(bf16_t, WS_PROJ), p.in[4] + layer * 128, WSP(bf16_t, WKVB(layer)), WSP(bf16_t, WS_DK), WSP(bf16_t, WS_DVT), it, lane, wid);
#else
            zero_cols(WSP(bf16_t, WS_MIXED), 256, 256, bid * 512 + tid, G * 512);
#endif
#if EN_RET
            for (int rp_ = 0; rp_ < RP_RKV; ++rp_) for (int it = bid; it < 512; it += G) ret_kv_item(lds, WSP(bf16_t, WS_PROJ), WSP(float, WS_KVT), it, tid);
#else
            zero_cols(WSP(bf16_t, WS_MIXED), 0, 256, bid * 512 + tid, G * 512);
#endif
        }
        if (rep_ + 1 < REP_MIXA) GSYNC();
        }
        GSYNC();
        for (int rep_ = 0; rep_ < REP_MIXB; ++rep_) {
        {
            PHASE_VARS();
#if EN_DSA
            for (int rp_ = 0; rp_ < RP_ATT; ++rp_) for (int it = bid; it < 256; it += G) {
                const int bh = it & 7, pr = (it >> 3) & 31; const int b = bh >> 2, h = bh & 3;
                const int w4 = wid & 3, qs = pr * 128 + w4 * 32, ql = (63 - pr) * 128 + w4 * 32, ns = qs / 32 + 1, nl = ql / 32 + 1, x = (nl - ns) >> 1;
                LASP float* pbuf = (LASP float*)((LASP unsigned char*)lds) + w4 * (34 * 64);
                if (rp_) __syncthreads();
                if (wid < 4) { dsa_att_wave<0>(WSP(bf16_t, WS_PROJ), WSP(bf16_t, WS_DK), WSP(bf16_t, WS_DVT), (const unsigned*)WSP(unsigned char, WS_BM), WSP(bf16_t, WS_MIXED), b, h, qs, 0, ns, pbuf, lane);
                               dsa_att_wave<1>(WSP(bf16_t, WS_PROJ), WSP(bf16_t, WS_DK), WSP(bf16_t, WS_DVT), (const unsigned*)WSP(unsigned char, WS_BM), WSP(bf16_t, WS_MIXED), b, h, ql, 0, x, pbuf, lane); }
                else dsa_att_wave<2>(WSP(bf16_t, WS_PROJ), WSP(bf16_t, WS_DK), WSP(bf16_t, WS_DVT), (const unsigned*)WSP(unsigned char, WS_BM), WSP(bf16_t, WS_MIXED), b, h, ql, x, nl, pbuf, lane);
                __syncthreads();
            }
#endif
#if EN_RET
            for (int rp_ = 0; rp_ < RP_ROUT; ++rp_) for (int it = bid; it < 512; it += G) {
                const int bh = it & 7, c = (it >> 3) & 31;
                ret_out_item(lds, WSP(bf16_t, WS_PROJ), WSP(float, WS_KVT), p.in[3] + layer * 256, WSP(bf16_t, WS_MIXED), bh * 64 + ((it < 256) ? c : 63 - c), tid, lane, wid); }
#endif
        }
        if (rep_ + 1 < REP_MIXB) GSYNC();
        }
        GSYNC();
        {
            PHASE_VARS();
            pg8::Gemm g{WSP(bf16_t, WS_MIXED), WSP(bf16_t, WOUTB(layer)), M, DM, DM}; pg8::StaticOrder So; So.init(M, DM, G, bid);
            pg8::EpiResidB E{WSP(bf16_t, WS_XB), DM, SSQ(2 * layer + 1)};
            pg8::gemm_phase<pg8::EpiResidB, pg8::StaticOrder, false, true>(gl, g, So, E);
        }
        TEAM_SYNC(0);
        for (int rep_ = 0; rep_ < REP_GUP; ++rep_) {
        {
            PHASE_VARS();
            pg8::Gemm g{WSP(bf16_t, WS_XB), WSP(bf16_t, WS_WUP), M, DFF, DM}; pg8::StaticOrder So; So.init(M, DFF, G, bid);
            pg8::EpiBf16<2> E{WSP(bf16_t, WS_HID), DFF, 0, -1, 1 << 30, SSQ(2 * layer + 1)};
            pg8::gemm_phase<pg8::EpiBf16<2>, pg8::StaticOrder, true, true>(gl, g, So, E);
        }
        if (rep_ + 1 < REP_GUP) GSYNC();
        }
        TEAM_SYNC(1);
        {
            PHASE_VARS();
            pg8::Gemm g{WSP(bf16_t, WS_HID), WSP(bf16_t, WS_WDN), M, DM, DFF}; pg8::StaticOrder So; So.init(M, DM, G, bid);
            pg8::EpiResidB E{WSP(bf16_t, WS_XB), DM, SSQ(2 * layer + 2)};
            pg8::gemm_phase<pg8::EpiResidB, pg8::StaticOrder, false, true>(gl, g, So, E);
        }
        GSYNC();
    }
    PHASE_VARS();
    for (int m = gw; m < M; m += NGW) final_row(WSP(bf16_t, WS_XB) + (size_t)m * DM, p.in[11], SSQ(8) + m, p.out + (size_t)m * DM, lane);
}

extern "C" void kernel_launch(void* const* d_in, const int* in_sizes, int n_in, void* d_out, int out_size, void* d_ws, size_t ws_size, hipStream_t stream) {
    static int grid = 0;
    if (grid == 0) {
        if (n_in != 12 || in_sizes[0] != M * DM || out_size != M * DM || ws_size < WS_END) { fprintf(stderr, "kernel_launch: unexpected shapes (n_in %d, in0 %d, out %d, ws %zu); nothing launched\n", n_in, n_in > 0 ? in_sizes[0] : -1, out_size, ws_size); grid = -1; return; }
        int dev = 0, cus = 0, per_cu = 0;
        hipGetDevice(&dev); hipDeviceGetAttribute(&cus, hipDeviceAttributeMultiprocessorCount, dev);
        hipFuncSetAttribute((const void*)hymba_fwd, hipFuncAttributeMaxDynamicSharedMemorySize, LDS_BYTES);
        hipOccupancyMaxActiveBlocksPerMultiprocessor(&per_cu, (const void*)hymba_fwd, 512, LDS_BYTES);
        if (per_cu < 1) { fprintf(stderr, "kernel_launch: occupancy query reports %d blocks per CU\n", per_cu); per_cu = 1; }
        (void)hipGetLastError();
        grid = cus * per_cu; if (grid > 256) grid = 256;
    }
    if (grid < 0) return;
    if (hipMemsetAsync(d_ws, 0, 1u << 20, stream) != hipSuccess) { fprintf(stderr, "kernel_launch: hipMemsetAsync failed\n"); return; }
    Params p{};
    for (int i = 0; i < 12; ++i) p.in[i] = (const float*)d_in[i];
    p.out = (float*)d_out; p.ws = (unsigned char*)d_ws;
    void* args[] = {&p};
    hipError_t e = hipLaunchCooperativeKernel((const void*)hymba_fwd, dim3(grid), dim3(512), args, LDS_BYTES, stream);
    if (e != hipSuccess) fprintf(stderr, "cooperative launch failed: %s (grid %d)\n", hipGetErrorString(e), grid);
}
```

```cpp
#include <hip/hip_runtime.h>
#include <hip/hip_cooperative_groups.h>
#include <cstdio>
#include <cstdint>
namespace cg = cooperative_groups;
namespace pg8 {
#define PG8_LAS __attribute__((address_space(3)))
typedef unsigned short bf16_t;
typedef short bf16x8 __attribute__((ext_vector_type(8)));
typedef float f32x4 __attribute__((ext_vector_type(4)));
typedef unsigned u32x4 __attribute__((ext_vector_type(4)));
constexpr int BM = 256, BK = 64, HALF = 128, HTB = HALF * BK * 2  , STAGE_BYTES = 8 * HTB, NXCD = 8, WGM = 8;

__host__ __device__ __forceinline__ int lds_byte(int r, int c) { const int st = (r >> 4) * 2 + (c >> 5), rr = r & 15, cc = c & 31, ob = rr * 64 + cc * 2; return st * 1024 + (ob ^ (((ob >> 9) & 1) << 5)); }
__host__ __device__ __forceinline__ void stage_rc(int b, int& R, int& C) { const int st = b / 1024, sb = b % 1024, swz = sb ^ (((sb >> 9) & 1) << 5); R = (st >> 1) * 16 + swz / 64; C = (st & 1) * 32 + (swz % 64) / 2; }
__host__ __device__ __forceinline__ int perm32(int rho) { const int n = rho >> 4, i = rho & 15; return 8 * (i >> 2) + 4 * n + (i & 3); }

struct Unit { int pm, pn; };
struct Gemm { const bf16_t* A; const bf16_t* Bt; int M, N, K; };

struct StaticOrder {
    int nM, nN, nwg, G, c;
    __host__ __device__ void init(int M, int N, int G_, int c_) { nM = M / BM; nN = N / BM; nwg = nM * nN; G = G_; c = c_; }
    __host__ __device__ bool next(int i, Unit& u) const {
        const long L = (long)i * G + c; if (L >= nwg) return false;
        int wgid = (int)L; { const int q = nwg / NXCD, r = nwg % NXCD, xcd = wgid % NXCD, off = wgid / NXCD; wgid = (xcd < r ? xcd * (q + 1) : r * (q + 1) + (xcd - r) * q) + off; }
        const int nig = WGM * nN, gid = wgid / nig, fm = gid * WGM, gsz = (nM - fm) < WGM ? (nM - fm) : WGM;
        u.pm = fm + ((wgid % nig) % gsz); u.pn = (wgid % nig) / gsz; return true;
    }
    __device__ __forceinline__ void a_ready(const Unit&) const {}
    __device__ __forceinline__ void done(const Unit&) const {}
};
__device__ __forceinline__ unsigned cvt_pk_bf16(float lo, float hi) { unsigned r; asm volatile("v_cvt_pk_bf16_f32 %0, %1, %2" : "=v"(r) : "v"(lo), "v"(hi)); return r; }
typedef float f32x2 __attribute__((ext_vector_type(2)));
typedef unsigned u32x2 __attribute__((ext_vector_type(2)));
template <int ACT> struct EpiBf16 {
    static constexpr bool PERM = true, AFTER_DRAIN = false;
    bf16_t* O; int ldc; int slot_rows; int frag_slot; int perm_lo; const float* ssq;
    __device__ __forceinline__ void operator()(const f32x4 (&acc)[2][2][4][2], const Unit& u, int wr, int wc, int fr, int fq) const {
        const int row0 = u.pm * BM + wr * 64 + fr + (slot_rows ? (u.pn * 4 + (wc >> 1)) * slot_rows : 0); const int col0 = (slot_rows ? (wc & 1) * 32 : u.pn * BM + wc * 32) + 8 * fq;
        unsigned sraw[2][4];
#pragma unroll
        for (int ai = 0; ai < 2; ++ai)
#pragma unroll
            for (int m = 0; m < 4; ++m) sraw[ai][m] = __hip_atomic_load((const unsigned*)ssq + (u.pm * BM + wr * 64 + fr + ai * HALF + m * 16), __ATOMIC_RELAXED, __HIP_MEMORY_SCOPE_AGENT);
#pragma unroll
        for (int ai = 0; ai < 2; ++ai)
#pragma unroll
            for (int m = 0; m < 4; ++m) { bf16_t* rowp = O + (size_t)(row0 + ai * HALF + m * 16) * ldc + col0;
                const float rs = rsqrtf((float)sraw[ai][m] * (1.f / (1024.f * 1024.f)) + 1e-6f);
#pragma unroll
                for (int bj = 0; bj < 2; ++bj) { f32x4 v0 = acc[ai][bj][m][0] * rs, v1 = acc[ai][bj][m][1] * rs;
                    if (ACT == 2) {
#pragma unroll
                        for (int e = 0; e < 4; ++e) { const float a = fmaxf(v0[e], 0.f), b = fmaxf(v1[e], 0.f); v0[e] = a * a; v1[e] = b * b; } }
                    u32x4 w; w.x = cvt_pk_bf16(v0[0], v0[1]); w.y = cvt_pk_bf16(v0[2], v0[3]); w.z = cvt_pk_bf16(v1[0], v1[1]); w.w = cvt_pk_bf16(v1[2], v1[3]);
                    bf16_t* dst = rowp + (slot_rows ? (size_t)bj * 2 * slot_rows * 64 : (size_t)(bj * HALF));
                    const int slot = u.pn * 4 + (wc >> 1) + 2 * bj;
                    if (slot_rows && (slot == frag_slot || slot >= perm_lo)) { int tok = u.pm * BM + wr * 64 + fr + ai * HALF + m * 16; const int c0 = (wc & 1) * 32 + 8 * fq;
                        if (slot >= perm_lo) tok = (tok & ~8191) + (tok & 15) * 512 + ((tok & 8191) >> 4);
                        dst = O + (size_t)slot * slot_rows * 64 + (size_t)(tok >> 5) * 2048 + ((((c0 >> 4) * 2 + ((c0 >> 3) & 1)) * 32 + (tok & 31)) * 8); }
                    *(u32x4*)dst = w; } }
    }
};
struct EpiResidB {
    static constexpr bool PERM = true, AFTER_DRAIN = false;
    bf16_t* xb; int ldc; float* ssq;
    __device__ __forceinline__ void operator()(const f32x4 (&acc)[2][2][4][2], const Unit& u, int wr, int wc, int fr, int fq) const {
        const int col0 = u.pn * BM + wc * 32 + 8 * fq;
#pragma unroll
        for (int ai = 0; ai < 2; ++ai) {
            u32x4 bs[4][2];
#pragma unroll
            for (int m = 0; m < 4; ++m)
#pragma unroll
                for (int bj = 0; bj < 2; ++bj) bs[m][bj] = *(const u32x4*)(xb + (size_t)(u.pm * BM + ai * HALF + wr * 64 + m * 16 + fr) * ldc + col0 + bj * HALF);
            asm volatile("" ::: "memory");
#pragma unroll
            for (int m = 0; m < 4; ++m) { bf16_t* rowp = xb + (size_t)(u.pm * BM + ai * HALF + wr * 64 + m * 16 + fr) * ldc + col0;
                float sq = 0.f;
#pragma unroll
                for (int bj = 0; bj < 2; ++bj) { const u32x4 b = bs[m][bj]; f32x4 v0 = acc[ai][bj][m][0], v1 = acc[ai][bj][m][1];
                    v0[0] += __uint_as_float(b.x << 16); v0[1] += __uint_as_float(b.x & 0xffff0000u); v0[2] += __uint_as_float(b.y << 16); v0[3] += __uint_as_float(b.y & 0xffff0000u);
                    v1[0] += __uint_as_float(b.z << 16); v1[1] += __uint_as_float(b.z & 0xffff0000u); v1[2] += __uint_as_float(b.w << 16); v1[3] += __uint_as_float(b.w & 0xffff0000u);
                    sq += ((v0[0] * v0[0] + v0[1] * v0[1]) + (v0[2] * v0[2] + v0[3] * v0[3])) + ((v1[0] * v1[0] + v1[1] * v1[1]) + (v1[2] * v1[2] + v1[3] * v1[3]));
                    u32x4 w; w.x = cvt_pk_bf16(v0[0], v0[1]); w.y = cvt_pk_bf16(v0[2], v0[3]); w.z = cvt_pk_bf16(v1[0], v1[1]); w.w = cvt_pk_bf16(v1[2], v1[3]);
                    *(u32x4*)(rowp + bj * HALF) = w; }
                { auto r16 = __builtin_amdgcn_permlane16_swap(__float_as_uint(sq), __float_as_uint(sq), false, false); sq = __uint_as_float(r16[0]) + __uint_as_float(r16[1]);
                  auto r32 = __builtin_amdgcn_permlane32_swap(__float_as_uint(sq), __float_as_uint(sq), false, false); sq = __uint_as_float(r32[0]) + __uint_as_float(r32[1]); }
                if (fq == 0) __hip_atomic_fetch_add((unsigned*)ssq + (u.pm * BM + ai * HALF + wr * 64 + m * 16 + fr), (unsigned)(sq * 1024.f + 0.5f), __ATOMIC_RELAXED, __HIP_MEMORY_SCOPE_AGENT); }
            asm volatile("" ::: "memory");
        }
    }
};

template <class Epi, class Sched, bool ALIGN_EPI = false, bool SP2 = false>
__device__ __forceinline__ void gemm_phase(PG8_LAS unsigned char* lds, const Gemm g, const Sched& S, const Epi& E) {
    int tid_l = threadIdx.x; asm volatile("" : "+v"(tid_l));
    const int tid = tid_l, wid = __builtin_amdgcn_readfirstlane(tid >> 6), lane = tid & 63, wr = wid >> 2, wc = wid & 3, fr = lane & 15, fq = lane >> 4;
    const int K = g.K, nt = K / BK;
    unsigned voffA[2], voffB[2];
#pragma unroll
    for (int i = 0; i < 2; ++i) { int R, C; stage_rc(tid * 16 + i * 8192, R, C); const int Rb = Epi::PERM ? ((R & ~31) + perm32(R & 31)) : R;
        voffA[i] = (unsigned)(R * K + C) * 2u; voffB[i] = (unsigned)(Rb * K + C) * 2u; }
    const size_t kstep = (size_t)(BK * 2);
    const size_t hstep = (size_t)HALF * K * 2;
    const size_t tstep = 2 * hstep;
    const unsigned ldsw = (unsigned)wid * 1024u;
    const int aoff = lds_byte(wr * 64 + fr, fq * 8), boff = lds_byte(wc * 32 + fr, fq * 8);
#define PG8_SA(b, h) (((b) * 2 + (h)) * HTB)
#define PG8_SB(b, h) ((4 + (b) * 2 + (h)) * HTB)
#define PG8_STAGE(bufoff, gbase, voff) do { _Pragma("unroll") for (int _i = 0; _i < 2; ++_i) \
        __builtin_amdgcn_global_load_lds((const unsigned*)((const char*)(gbase) + (voff)[_i]), (PG8_LAS unsigned*)(lds + (bufoff) + ldsw + _i * 8192), 16, 0, 0); } while (0)
#define PG8_LDA(dst, b, h) do { _Pragma("unroll") for (int m = 0; m < 4; ++m) _Pragma("unroll") for (int k = 0; k < 2; ++k) dst[m][k] = *(const PG8_LAS bf16x8*)(lds + PG8_SA(b, h) + aoff + m * 2048 + k * 1024); } while (0)
#define PG8_LDB(dst, b, h) do { _Pragma("unroll") for (int n = 0; n < 2; ++n) _Pragma("unroll") for (int k = 0; k < 2; ++k) dst[n][k] = *(const PG8_LAS bf16x8*)(lds + PG8_SB(b, h) + boff + n * 2048 + k * 1024); } while (0)
#define PG8_MMA(ai, bj, At, Bt) do { __builtin_amdgcn_s_setprio(1); _Pragma("unroll") for (int m = 0; m < 4; ++m) _Pragma("unroll") for (int n = 0; n < 2; ++n) _Pragma("unroll") for (int k = 0; k < 2; ++k) \
        acc[ai][bj][m][n] = __builtin_amdgcn_mfma_f32_16x16x32_bf16(Bt[n][k], At[m][k], acc[ai][bj][m][n], 0, 0, 0); __builtin_amdgcn_s_setprio(0); } while (0)
#define PG8_WAIT_V(n) asm volatile("s_waitcnt vmcnt(" #n ")" ::: "memory")
#define PG8_WAIT_L(n) asm volatile("s_waitcnt lgkmcnt(" #n ")" ::: "memory")
#define PG8_BAR __builtin_amdgcn_s_barrier()
#define PG8_SCHED __builtin_amdgcn_sched_barrier(0)
    Unit cur, nxt; int ui = 0;
    if (!S.next(0, cur)) return;
    f32x4 acc[2][2][4][2];
#pragma unroll
    for (int a = 0; a < 2; ++a)
#pragma unroll
        for (int b = 0; b < 2; ++b)
#pragma unroll
            for (int m = 0; m < 4; ++m)
#pragma unroll
                for (int n = 0; n < 2; ++n) acc[a][b][m][n] = (f32x4){0.f, 0.f, 0.f, 0.f};
    bf16x8 At[4][2], B0[2][2], B1[2][2];
    const char* cA = (const char*)g.A + (size_t)cur.pm * tstep; const char* cB = (const char*)g.Bt + (size_t)cur.pn * tstep;
    S.a_ready(cur);
    if constexpr (SP2) {
        PG8_STAGE(PG8_SB(0, 0), cB, voffB); PG8_STAGE(PG8_SB(0, 1), cB + hstep, voffB); PG8_STAGE(PG8_SA(0, 0), cA, voffA); PG8_STAGE(PG8_SA(0, 1), cA + hstep, voffA);
        if (wr == 1) PG8_BAR;
        PG8_WAIT_V(2); PG8_BAR;
        PG8_STAGE(PG8_SB(1, 0), cB + kstep, voffB); PG8_STAGE(PG8_SA(1, 0), cA + kstep, voffA); PG8_STAGE(PG8_SB(1, 1), cB + hstep + kstep, voffB);
        PG8_WAIT_V(6); PG8_BAR;
    } else {
        PG8_STAGE(PG8_SB(0, 0), cB, voffB); PG8_STAGE(PG8_SA(0, 0), cA, voffA); PG8_STAGE(PG8_SB(0, 1), cB + hstep, voffB); PG8_STAGE(PG8_SA(0, 1), cA + hstep, voffA);
        if (wr == 1) PG8_BAR;
        PG8_WAIT_V(4); PG8_BAR;
        PG8_STAGE(PG8_SB(1, 0), cB + kstep, voffB); PG8_STAGE(PG8_SA(1, 0), cA + kstep, voffA); PG8_STAGE(PG8_SB(1, 1), cB + hstep + kstep, voffB);
        PG8_WAIT_V(6); PG8_BAR;
    }
    for (;;) {
        const bool has_next = S.next(ui + 1, nxt);
        const char* nA = has_next ? (const char*)g.A + (size_t)nxt.pm * tstep : cA; const char* nB = has_next ? (const char*)g.Bt + (size_t)nxt.pn * tstep : cB;
        for (int t = 0; t < nt; t += 2) {
            const bool last = (t == nt - 2);
            const char* a1 = cA + (size_t)(t + 1) * kstep;
            const char* a2 = last ? nA : cA + (size_t)(t + 2) * kstep; const char* b2 = last ? nB : cB + (size_t)(t + 2) * kstep;
            const char* a3 = a2 + kstep; const char* b3 = b2 + kstep;
            if (last && has_next) S.a_ready(nxt);
            if constexpr (SP2) {
            PG8_LDB(B0, 0, 0); PG8_LDB(B1, 0, 1); PG8_SCHED; PG8_LDA(At, 0, 0); PG8_STAGE(PG8_SA(1, 1), a1 + hstep, voffA);
            PG8_WAIT_V(8); PG8_WAIT_L(0); PG8_BAR; PG8_MMA(0, 0, At, B0); PG8_MMA(0, 1, At, B1); PG8_BAR; PG8_SCHED;
            PG8_LDA(At, 0, 1); PG8_STAGE(PG8_SB(0, 0), b2, voffB); PG8_STAGE(PG8_SB(0, 1), b2 + hstep, voffB); PG8_STAGE(PG8_SA(0, 0), a2, voffA);
            PG8_WAIT_V(8); PG8_WAIT_L(0); PG8_BAR; PG8_MMA(1, 0, At, B0); PG8_MMA(1, 1, At, B1); PG8_BAR; PG8_SCHED;
            PG8_LDB(B0, 1, 0); PG8_LDB(B1, 1, 1); PG8_SCHED; PG8_LDA(At, 1, 0); PG8_STAGE(PG8_SA(0, 1), a2 + hstep, voffA);
            PG8_WAIT_V(8); PG8_WAIT_L(0); PG8_BAR; PG8_MMA(0, 0, At, B0); PG8_MMA(0, 1, At, B1); PG8_BAR; PG8_SCHED;
            PG8_LDA(At, 1, 1); PG8_STAGE(PG8_SB(1, 0), b3, voffB); PG8_STAGE(PG8_SB(1, 1), b3 + hstep, voffB); PG8_STAGE(PG8_SA(1, 0), a3, voffA);
            PG8_WAIT_V(8); PG8_WAIT_L(0); PG8_BAR; PG8_MMA(1, 0, At, B0); PG8_MMA(1, 1, At, B1); PG8_BAR; PG8_SCHED;
            } else {
            PG8_LDB(B0, 0, 0); PG8_SCHED; PG8_LDA(At, 0, 0); PG8_STAGE(PG8_SA(1, 1), a1 + hstep, voffA);
            PG8_WAIT_L(8); PG8_BAR; PG8_WAIT_L(0); PG8_MMA(0, 0, At, B0); PG8_BAR; PG8_SCHED;
            PG8_LDB(B1, 0, 1); PG8_STAGE(PG8_SB(0, 0), b2, voffB);
            PG8_BAR; PG8_WAIT_L(0); PG8_MMA(0, 1, At, B1); PG8_BAR;
            PG8_LDA(At, 0, 1); PG8_STAGE(PG8_SA(0, 0), a2, voffA);
            PG8_BAR; PG8_WAIT_L(0); PG8_MMA(1, 0, At, B0); PG8_BAR; PG8_SCHED;
            PG8_STAGE(PG8_SB(0, 1), b2 + hstep, voffB);
            PG8_WAIT_V(6); PG8_BAR; PG8_MMA(1, 1, At, B1); PG8_BAR;
            PG8_LDB(B0, 1, 0); PG8_SCHED; PG8_LDA(At, 1, 0); PG8_STAGE(PG8_SA(0, 1), a2 + hstep, voffA);
            PG8_WAIT_L(8); PG8_BAR; PG8_WAIT_L(0); PG8_MMA(0, 0, At, B0); PG8_BAR; PG8_SCHED;
            PG8_LDB(B1, 1, 1); PG8_STAGE(PG8_SB(1, 0), b3, voffB);
            PG8_BAR; PG8_WAIT_L(0); PG8_MMA(0, 1, At, B1); PG8_BAR;
            PG8_LDA(At, 1, 1); PG8_STAGE(PG8_SA(1, 0), a3, voffA);
            PG8_BAR; PG8_WAIT_L(0); PG8_MMA(1, 0, At, B0); PG8_BAR; PG8_SCHED;
            PG8_STAGE(PG8_SB(1, 1), b3 + hstep, voffB);
            PG8_WAIT_V(6); PG8_BAR; PG8_MMA(1, 1, At, B1); PG8_BAR;
            }
        }
        if constexpr (ALIGN_EPI) { if (wr == 0) PG8_BAR; }
        if constexpr (!Epi::AFTER_DRAIN) { E(acc, cur, wr, wc, fr, fq); S.done(cur); }
        if (!has_next) break;
#pragma unroll
        for (int a = 0; a < 2; ++a)
#pragma unroll
            for (int b = 0; b < 2; ++b)
#pragma unroll
                for (int m = 0; m < 4; ++m)
#pragma unroll
                    for (int n = 0; n < 2; ++n) acc[a][b][m][n] = (f32x4){0.f, 0.f, 0.f, 0.f};
        cur = nxt; cA = nA; cB = nB; ++ui;
        if constexpr (ALIGN_EPI) { if (wr == 1) PG8_BAR; }
    }
    PG8_WAIT_V(0);
    if constexpr (!ALIGN_EPI) { if (wr == 0) PG8_BAR; }
    PG8_BAR;
    if constexpr (Epi::AFTER_DRAIN) { E.fused(acc, cur, wr, wc, fr, fq, lds, wid, lane); S.done(cur); }
#undef PG8_SA
#undef PG8_SB
#undef PG8_STAGE
#undef PG8_LDA
#undef PG8_LDB
#undef PG8_MMA
#undef PG8_WAIT_V
#undef PG8_WAIT_L
#undef PG8_BAR
#undef PG8_SCHED
}
}

#ifndef RP_DIL
#define RP_DIL 1
#endif
#ifndef RP_IDX
#define RP_IDX 1
#endif
#ifndef RP_DKV
#define RP_DKV 1
#endif
#ifndef RP_RKV
#define RP_RKV 1
#endif
#ifndef RP_ATT
#define RP_ATT 1
#endif
#ifndef RP_ROUT
#define RP_ROUT 1
#endif
#ifndef RP_SEL
#define RP_SEL 1
#endif
#ifndef RP_IDXMAIN
#define RP_IDXMAIN 1
#endif
#ifndef PROBE_ATOM
#define PROBE_ATOM 0
#endif
#ifndef PROBE_MFMA
#define PROBE_MFMA 0
#endif
#ifndef PROBE_PASSA
#define PROBE_PASSA 0
#endif
#ifndef PROBE_VALU
#define PROBE_VALU 0
#endif
#ifndef IDX_NW
#define IDX_NW 8
#endif
#ifndef REP_MIXA
#define REP_MIXA 1
#endif
#ifndef REP_MIXB
#define REP_MIXB 1
#endif
#ifndef REP_PRE
#define REP_PRE 1
#endif
#ifndef REP_GIN
#define REP_GIN 1
#endif
#ifndef REP_GUP
#define REP_GUP 1
#endif
#ifndef EN_RET
#define EN_RET 1
#endif
#ifndef EN_DSA
#define EN_DSA 1
#endif
#ifndef EN_DIL
#define EN_DIL 1
#endif
typedef unsigned short bf16_t;
typedef short bf16x8 __attribute__((ext_vector_type(8)));
typedef float f32x4 __attribute__((ext_vector_type(4)));
typedef float f32x16 __attribute__((ext_vector_type(16)));
typedef unsigned u32x4 __attribute__((ext_vector_type(4)));
typedef unsigned u32x2 __attribute__((ext_vector_type(2)));
constexpr int NB = 2, S = 8192, DM = 1024, DEPTH = 4, M = NB * S, DFF = 4096;
constexpr int NIN = 3528, NP = 3584;
constexpr int C_RQ = 0, C_RK = 256, C_RV = 512, C_RG = 768, C_DQ = 1024, C_CKV = 1280, C_QI = 1408, C_KI = 1920, C_WI = 1984, C_LQ = 2048, C_LK = 2560, C_LV = 3072;
constexpr float NORM_EPS = 1e-6f;
#define PJ(base, row, col) ((base) + ((size_t)((col) >> 6) * M + (size_t)(row)) * 64 + ((col) & 63))
constexpr size_t MiB = 1u << 20;
constexpr size_t WS_CTL = 0;
constexpr size_t WS_WKV = 1 * MiB;
constexpr size_t WS_WIN = 2 * MiB;
constexpr size_t WS_WOUT = 9 * MiB;
constexpr size_t WS_SLOTA = 12 * MiB;
constexpr size_t WS_XB = WS_SLOTA, WS_SSQ = 128 * 1024, WS_HX = WS_SLOTA, WS_SCR = WS_SLOTA, WS_XN = WS_SLOTA, WS_WUP = WS_SLOTA + 32 * MiB, WS_WDN = WS_SLOTA + 40 * MiB;
constexpr size_t SCR_PER_WG = 256 * 1024;
constexpr size_t WS_WIN2 = WS_SLOTA + 48 * MiB, WS_WOUT2 = WS_SLOTA + 55 * MiB, WS_WKV2 = WS_SLOTA + 58 * MiB;
#define WINB(l) (((l) & 1) ? WS_WIN2 : WS_WIN)
#define WOUTB(l) (((l) & 1) ? WS_WOUT2 : WS_WOUT)
#define WKVB(l) (((l) & 1) ? WS_WKV2 : WS_WKV)
constexpr size_t WS_MIXED = 76 * MiB;
constexpr size_t WS_PROJ = 108 * MiB;
constexpr size_t WS_HID = 108 * MiB;
constexpr size_t WS_KVT = 220 * MiB;
constexpr size_t WS_DK = 228 * MiB;
constexpr size_t WS_DVT = 236 * MiB;
constexpr size_t WS_BM = 244 * MiB;
constexpr size_t WS_END = 260 * MiB;
constexpr int LDS_BYTES = 147456;

__device__ __forceinline__ float bf2f(bf16_t v) { return __uint_as_float(((unsigned)v) << 16); }
__device__ __forceinline__ unsigned f2bf(float f) { unsigned u = __float_as_uint(f); return (u + 0x7fffu + ((u >> 16) & 1u)) >> 16; }
__device__ __forceinline__ unsigned pk2(float lo, float hi) { return f2bf(lo) | (f2bf(hi) << 16); }
__device__ __forceinline__ float wave_sum(float v) {
#pragma unroll
    for (int o = 1; o < 64; o <<= 1) v += __shfl_xor(v, o);
    return v;
}
__device__ __forceinline__ float wave_allsum(float v) {
    v += __int_as_float(__builtin_amdgcn_update_dpp(0, __float_as_int(v), 0xB1, 0xf, 0xf, true));
    v += __int_as_float(__builtin_amdgcn_update_dpp(0, __float_as_int(v), 0x4E, 0xf, 0xf, true));
    v += __int_as_float(__builtin_amdgcn_update_dpp(0, __float_as_int(v), 0x141, 0xf, 0xf, true));
    v += __int_as_float(__builtin_amdgcn_update_dpp(0, __float_as_int(v), 0x140, 0xf, 0xf, true));
    { auto r16 = __builtin_amdgcn_permlane16_swap(__float_as_uint(v), __float_as_uint(v), false, false); v = __uint_as_float(r16[0]) + __uint_as_float(r16[1]);
      auto r32 = __builtin_amdgcn_permlane32_swap(__float_as_uint(v), __float_as_uint(v), false, false); v = __uint_as_float(r32[0]) + __uint_as_float(r32[1]); }
    return v;
}
__device__ __forceinline__ int crow(int r, int hi) { return (r & 3) + 8 * (r >> 2) + 4 * hi; }
__device__ __forceinline__ bf16x8 pack8(const float* p) { u32x4 w; w.x = pk2(p[0], p[1]); w.y = pk2(p[2], p[3]); w.z = pk2(p[4], p[5]); w.w = pk2(p[6], p[7]); return __builtin_bit_cast(bf16x8, w); }
__device__ __forceinline__ bf16x8 join8(u32x2 a, u32x2 b) { u32x4 w; w.x = a.x; w.y = a.y; w.z = b.x; w.w = b.y; return __builtin_bit_cast(bf16x8, w); }
__device__ __forceinline__ unsigned cvtpk(float lo, float hi) { typedef float f2_t __attribute__((ext_vector_type(2))); typedef __bf16 b2_t __attribute__((ext_vector_type(2))); f2_t v = {lo, hi}; b2_t bb = __builtin_convertvector(v, b2_t); return __builtin_bit_cast(unsigned, bb); }
__device__ __forceinline__ bf16x8 pack8h(const float* p) { u32x4 w; w.x = cvtpk(p[0], p[1]); w.y = cvtpk(p[2], p[3]); w.z = cvtpk(p[4], p[5]); w.w = cvtpk(p[6], p[7]); return __builtin_bit_cast(bf16x8, w); }
__device__ __forceinline__ float fmx(float a, float b) { return __builtin_elementwise_maximum(a, b); }
__device__ __forceinline__ float xhalf_max(float v) { auto rr = __builtin_amdgcn_permlane32_swap(__float_as_uint(v), __float_as_uint(v), false, false); return fmx(__uint_as_float(rr[0]), __uint_as_float(rr[1])); }
__device__ __forceinline__ float xhalf_sum(float v) { auto rr = __builtin_amdgcn_permlane32_swap(__float_as_uint(v), __float_as_uint(v), false, false); return __uint_as_float(rr[0]) + __uint_as_float(rr[1]); }
__device__ __forceinline__ int vperm32(int kk) { return (kk & 16) | ((kk & 4) << 1) | ((kk & 8) >> 1) | (kk & 3); }
__device__ __forceinline__ float max0(float x) { return __builtin_amdgcn_fmed3f(x, 0.f, __builtin_inff()); }
#define MFMA32(a, b, c) __builtin_amdgcn_mfma_f32_32x32x16_bf16((a), (b), (c), 0, 0, 0)
#define LDSW() asm volatile("s_waitcnt lgkmcnt(0)" ::: "memory")
#define LDSO() asm volatile("" ::: "memory")

template <int MODE, bool SCALE>
__device__ __forceinline__ void transpose_item(const float* __restrict__ W, int K, int N, bf16_t* WT, int nblk, float* scr, int item, int lane, const float* kscale = nullptr) {
    const int kb = item / nblk, nb = item % nblk, k0 = 64 * kb, n0 = 32 * nb;
    const int n4 = lane & 7, kk = lane >> 3, ng = n0 + 4 * n4;
    int sc = ng; if (MODE == 1) sc = (ng < 1992) ? ng : ((ng < 2048) ? -1 : ng - 56);
    const float keep = (sc >= 0) ? 1.f : 0.f; const int scc = (sc >= 0) ? sc : 0;
    const float* src = W + (size_t)(k0 + kk) * N + scc;
    f32x4 wv[8];
#pragma unroll
    for (int i = 0; i < 8; ++i) wv[i] = *(const f32x4*)(src + (size_t)(8 * i) * N);
    f32x4 ks0 = {1.f, 1.f, 1.f, 1.f}, ks1 = ks0;
    if (SCALE) { ks0 = *(const f32x4*)(kscale + k0 + 8 * (lane & 7)); ks1 = *(const f32x4*)(kscale + k0 + 8 * (lane & 7) + 4); }
#pragma unroll
    for (int i = 0; i < 8; ++i) { float* d = scr + (kk + 8 * i) * 33 + 4 * n4; d[0] = wv[i].x * keep; d[1] = wv[i].y * keep; d[2] = wv[i].z * keep; d[3] = wv[i].w * keep; }
    LDSW();
    const int c = lane & 7;
#pragma unroll
    for (int j = 0; j < 4; ++j) { const int nn = (lane >> 3) + 8 * j; const float* s = scr + (8 * c) * 33 + nn;
        u32x4 o; o.x = cvtpk(s[0 * 33] * ks0.x, s[1 * 33] * ks0.y); o.y = cvtpk(s[2 * 33] * ks0.z, s[3 * 33] * ks0.w); o.z = cvtpk(s[4 * 33] * ks1.x, s[5 * 33] * ks1.y); o.w = cvtpk(s[6 * 33] * ks1.z, s[7 * 33] * ks1.w);
        *(u32x4*)(WT + (size_t)(n0 + nn) * K + k0 + 8 * c) = o; }
    LDSW();
}
__device__ __forceinline__ void rms_row_bf16(const float* xrow, const float* w, bf16_t* orow, int lane) {
    const f32x4* xr = (const f32x4*)xrow + lane; const f32x4* wr = (const f32x4*)w + lane;
    f32x4 v[4]; float s = 0.f;
#pragma unroll
    for (int j = 0; j < 4; ++j) { v[j] = xr[64 * j]; s += (v[j].x * v[j].x + v[j].y * v[j].y) + (v[j].z * v[j].z + v[j].w * v[j].w); }
    const float rstd = rsqrtf(wave_sum(s) * (1.f / DM) + NORM_EPS);
    u32x2* o8 = (u32x2*)orow + lane;
#pragma unroll
    for (int j = 0; j < 4; ++j) { const f32x4 ww = wr[64 * j]; u32x2 o; o.x = pk2(v[j].x * rstd * ww.x, v[j].y * rstd * ww.y); o.y = pk2(v[j].z * rstd * ww.z, v[j].w * rstd * ww.w); o8[64 * j] = o; }
}
__device__ __forceinline__ void row_xb_ssq(const float* xrow, bf16_t* orow, float* ssq, int lane) {
    const f32x4* xr = (const f32x4*)xrow + lane;
    f32x4 v[4]; float s = 0.f;
#pragma unroll
    for (int j = 0; j < 4; ++j) { v[j] = xr[64 * j]; s += (v[j].x * v[j].x + v[j].y * v[j].y) + (v[j].z * v[j].z + v[j].w * v[j].w); }
    s = wave_sum(s);
    u32x2* o8 = (u32x2*)orow + lane;
#pragma unroll
    for (int j = 0; j < 4; ++j) { u32x2 o; o.x = cvtpk(v[j].x, v[j].y); o.y = cvtpk(v[j].z, v[j].w); o8[64 * j] = o; }
    if (lane == 0) __hip_atomic_store((unsigned*)ssq, (unsigned)(s * 1024.f + 0.5f), __ATOMIC_RELAXED, __HIP_MEMORY_SCOPE_AGENT);
}
__device__ __forceinline__ void row_xb_ssq4(const float* x, bf16_t* xb, float* ssq, int m0, int stride, int lane) {
    f32x4 v[4][4]; float s[4];
#pragma unroll
    for (int i = 0; i < 4; ++i) { const f32x4* xr = (const f32x4*)(x + (size_t)(m0 + i * stride) * DM) + lane;
#pragma unroll
        for (int j = 0; j < 4; ++j) v[i][j] = xr[64 * j]; }
#pragma unroll
    for (int i = 0; i < 4; ++i) { s[i] = 0.f;
#pragma unroll
        for (int j = 0; j < 4; ++j) s[i] += (v[i][j].x * v[i][j].x + v[i][j].y * v[i][j].y) + (v[i][j].z * v[i][j].z + v[i][j].w * v[i][j].w); }
#pragma unroll
    for (int o = 1; o < 64; o <<= 1) {
#pragma unroll
        for (int i = 0; i < 4; ++i) s[i] += __shfl_xor(s[i], o); }
#pragma unroll
    for (int i = 0; i < 4; ++i) { u32x2* o8 = (u32x2*)(xb + (size_t)(m0 + i * stride) * DM) + lane;
#pragma unroll
        for (int j = 0; j < 4; ++j) { u32x2 o; o.x = cvtpk(v[i][j].x, v[i][j].y); o.y = cvtpk(v[i][j].z, v[i][j].w); o8[64 * j] = o; }
        if (lane == 0) __hip_atomic_store((unsigned*)ssq + (m0 + i * stride), (unsigned)(s[i] * 1024.f + 0.5f), __ATOMIC_RELAXED, __HIP_MEMORY_SCOPE_AGENT); }
}
__device__ __forceinline__ void final_row4(const bf16_t* xb, const float* w, const float* ssq, float* out, int m0, int stride, int lane) {
    u32x4 b[4][2]; unsigned sr[4];
#pragma unroll
    for (int i = 0; i < 4; ++i) { const int mrow = m0 + i * stride; sr[i] = __hip_atomic_load((const unsigned*)ssq + mrow, __ATOMIC_RELAXED, __HIP_MEMORY_SCOPE_AGENT);
#pragma unroll
        for (int j = 0; j < 2; ++j) b[i][j] = *((const u32x4*)(xb + (size_t)mrow * DM) + lane + 64 * j); }
#pragma unroll
    for (int i = 0; i < 4; ++i) { const float rstd = rsqrtf((float)sr[i] * (1.f / (1024.f * DM)) + NORM_EPS);
#pragma unroll
        for (int j = 0; j < 2; ++j) { const u32x4 bb = b[i][j]; const f32x4* wr = (const f32x4*)w + 2 * lane + 128 * j; f32x4* o = (f32x4*)(out + (size_t)(m0 + i * stride) * DM) + 2 * lane + 128 * j;
            const f32x4 w0 = wr[0], w1 = wr[1]; f32x4 o0, o1;
            o0.x = __uint_as_float(bb.x << 16) * rstd * w0.x; o0.y = __uint_as_float(bb.x & 0xffff0000u) * rstd * w0.y; o0.z = __uint_as_float(bb.y << 16) * rstd * w0.z; o0.w = __uint_as_float(bb.y & 0xffff0000u) * rstd * w0.w;
            o1.x = __uint_as_float(bb.z << 16) * rstd * w1.x; o1.y = __uint_as_float(bb.z & 0xffff0000u) * rstd * w1.y; o1.z = __uint_as_float(bb.w << 16) * rstd * w1.z; o1.w = __uint_as_float(bb.w & 0xffff0000u) * rstd * w1.w;
            o[0] = o0; o[1] = o1; } }
}
__device__ __forceinline__ void final_row(const bf16_t* xrow, const float* w, const float* ssq, float* orow, int lane) {
    const float rstd = rsqrtf((float)__hip_atomic_load((const unsigned*)ssq, __ATOMIC_RELAXED, __HIP_MEMORY_SCOPE_AGENT) * (1.f / (1024.f * DM)) + NORM_EPS);
#pragma unroll
    for (int j = 0; j < 2; ++j) { const u32x4 b = *((const u32x4*)xrow + lane + 64 * j); const f32x4* wr = (const f32x4*)w + 2 * lane + 128 * j; f32x4* o = (f32x4*)orow + 2 * lane + 128 * j;
        const f32x4 w0 = wr[0], w1 = wr[1]; f32x4 o0, o1;
        o0.x = __uint_as_float(b.x << 16) * rstd * w0.x; o0.y = __uint_as_float(b.x & 0xffff0000u) * rstd * w0.y; o0.z = __uint_as_float(b.y << 16) * rstd * w0.z; o0.w = __uint_as_float(b.y & 0xffff0000u) * rstd * w0.w;
        o1.x = __uint_as_float(b.z << 16) * rstd * w1.x; o1.y = __uint_as_float(b.z & 0xffff0000u) * rstd * w1.y; o1.z = __uint_as_float(b.w << 16) * rstd * w1.z; o1.w = __uint_as_float(b.w & 0xffff0000u) * rstd * w1.w;
        o[0] = o0; o[1] = o1; }
}
__device__ __forceinline__ void rms_row_f32(const float* xrow, const float* w, float* orow, int lane) {
    const f32x4* xr = (const f32x4*)xrow + lane; const f32x4* wr = (const f32x4*)w + lane;
    f32x4 v[4]; float s = 0.f;
#pragma unroll
    for (int j = 0; j < 4; ++j) { v[j] = xr[64 * j]; s += (v[j].x * v[j].x + v[j].y * v[j].y) + (v[j].z * v[j].z + v[j].w * v[j].w); }
    const float rstd = rsqrtf(wave_sum(s) * (1.f / DM) + NORM_EPS);
    f32x4* o = (f32x4*)orow + lane;
#pragma unroll
    for (int j = 0; j < 4; ++j) { const f32x4 ww = wr[64 * j]; o[64 * j] = v[j] * rstd * ww; }
}
__device__ __forceinline__ void rot_cs(int pos, int i, float& c, float& s) {
    const float inv = exp2f(-(float)i * (13.287712379549449f / 32.f));
    float t = ((float)pos * inv) * 0.15915494309189535f; t = t - floorf(t);
    s = __builtin_amdgcn_sinf(t); c = __builtin_amdgcn_cosf(t);
}
__device__ __forceinline__ float log2_gamma(int h) { return log2f(1.f - exp2f(-5.f - (float)h)); }

__device__ __forceinline__ const bf16_t* dil_frag(const bf16_t* proj, int col, int b, int t, int hi) {
    const int pr = b * S + (t & 15) * 512 + (t >> 4);
    return proj + (size_t)(col >> 6) * M * 64 + (size_t)(pr >> 5) * 2048 + (hi * 32 + (pr & 31)) * 8;
}
#define LASP __attribute__((address_space(3)))
typedef short v4i16_t __attribute__((ext_vector_type(4)));
__device__ __forceinline__ u32x2 ldtr(LASP const unsigned char* p) { return __builtin_bit_cast(u32x2, __builtin_amdgcn_ds_read_tr16_b64_v4i16((LASP v4i16_t*)p)); }
__device__ __forceinline__ void dil_item(unsigned char* lds_g, const bf16_t* proj, bf16_t* mixed, int item, int tid, int lane, int wid) {
    LASP unsigned char* lds = (LASP unsigned char*)lds_g;
    const int b = item >> 7, h = (item >> 4) & 7, blk = item & 15, t0 = blk * 512;
    LASP float* lsebuf = (LASP float*)lds;
    LASP unsigned char* obuf = lds + 2048;
    LASP unsigned char* vt = lds + 2048 + 65536 + wid * 4096;
    const int r32 = lane & 31, hi = lane >> 5;
    const int rb = b * S;
    const int vsw = (r32 >> 1) & 3;
    const int vwr0 = r32 * 64 + ((hi ^ vsw) << 4), vwr1 = r32 * 64 + (((hi ^ vsw) ^ 2) << 4);
    const int vR = 4 * hi + ((lane & 15) >> 2), vcb = (16 * ((lane >> 4) & 1) + 4 * (lane & 3)) * 2;
    const int vrd = vR * 64 + ((((vcb >> 4) ^ ((vR >> 1) & 3))) << 4) + (vcb & 15);
    for (int br = 0; br < 3; ++br) {
        const int sh = 2 * br, dl = 1 << sh;
        const int rhoA = wid & (dl - 1), I0A = (t0 >> sh) + 32 * (wid >> sh), rhoB = (wid + 8) & (dl - 1), I0B = (t0 >> sh) + 32 * ((wid + 8) >> sh);
        const int kk0A = (I0A >= 128) ? 0 : (4 - (I0A >> 5)), kk0B = (I0B >= 128) ? 0 : (4 - (I0B >> 5));
        bf16x8 QA[4], QB[4];
        { const bf16_t* qa = dil_frag(proj, C_LQ + h * 64, b, rhoA + dl * (I0A + r32), hi); const bf16_t* qb = dil_frag(proj, C_LQ + h * 64, b, rhoB + dl * (I0B + r32), hi);
#pragma unroll
          for (int ks = 0; ks < 4; ++ks) { QA[ks] = *(const bf16x8*)(qa + 512 * ks); QB[ks] = *(const bf16x8*)(qb + 512 * ks); } }
        bf16x8 K0[4], K1[4], V0[4], V1[4]; f32x16 s0, s1;
#define DIL_RHO(i_) (((i_) < 5) ? rhoA : rhoB)
#define DIL_I0(i_) (((i_) < 5) ? I0A : I0B)
#define DIL_POS(i_) ({ const int ii_ = ((i_) < 10) ? (i_) : 9; int p_ = DIL_RHO(ii_) + dl * (DIL_I0(ii_) - 128 + 32 * (ii_ % 5) + r32); p_ < 0 ? 0 : p_; })
#define DIL_LOADK(K_, i_) do { const bf16_t* kp_ = dil_frag(proj, C_LK + h * 64, b, DIL_POS(i_), hi); _Pragma("unroll") for (int c = 0; c < 4; ++c) K_[c] = *(const bf16x8*)(kp_ + 512 * c); } while (0)
#define DIL_LOADV(V_, i_) do { const bf16_t* vp_ = dil_frag(proj, C_LV + h * 64, b, DIL_POS(i_), hi); _Pragma("unroll") for (int c = 0; c < 4; ++c) V_[c] = *(const bf16x8*)(vp_ + 512 * c); } while (0)
#define DIL_QK(s_, K_, i_) do { s_ = (f32x16){}; _Pragma("unroll") for (int ks = 0; ks < 4; ++ks) s_ = MFMA32(K_[ks], ((i_) < 5 ? QA[ks] : QB[ks]), s_); } while (0)
#define DIL_STEP(i_, sC, sN, KC, KN, VC, VN) do { constexpr int kk = (i_) % 5; const int kk0u = ((i_) < 5) ? kk0A : kk0B; \
        if (kk == 0) { o0 = (f32x16){}; o1 = (f32x16){}; m = -1e30f; l = 0.f; } \
        DIL_LOADK(KC, (i_) + 2); DIL_LOADV(VN, (i_) + 1); \
        if ((i_) + 1 < 10) DIL_QK(sN, KN, (i_) + 1); \
        if (kk >= kk0u) { \
            _Pragma("unroll") for (int c = 0; c < 4; ++c) *(LASP bf16x8*)(vt + (c >> 1) * 2048 + ((c & 1) ? vwr1 : vwr0)) = VC[c]; \
            float x[16], p[16]; float tmax = -1e30f; \
            if (kk == 0 || kk == 4) { \
                _Pragma("unroll") for (int r = 0; r < 16; ++r) { const int j = crow(r, hi); const bool ok = (kk == 0) ? (j >= r32) : (j <= r32); \
                    x[r] = ok ? sC[r] * (0.125f * 1.4426950408889634f) : -1e30f; tmax = fmx(tmax, x[r]); } \
            } else { \
                _Pragma("unroll") for (int r = 0; r < 16; ++r) { x[r] = sC[r] * (0.125f * 1.4426950408889634f); tmax = fmx(tmax, x[r]); } } \
            tmax = xhalf_max(tmax); \
            if (__any(tmax > m + 6.f)) { const float mn = fmx(m, tmax), alpha = __builtin_amdgcn_exp2f(m - mn); o0 = o0 * alpha; o1 = o1 * alpha; l *= alpha; m = mn; }     \
            float psum = 0.f; \
            _Pragma("unroll") for (int r = 0; r < 16; ++r) { p[r] = __builtin_amdgcn_exp2f(x[r] - m); psum += p[r]; } \
            l += psum; \
            const bf16x8 P0 = pack8h(p), P1 = pack8h(p + 8); \
            LDSO(); \
            { const u32x2 a00 = ldtr(vt + vrd), a01 = ldtr(vt + vrd + 512), a10 = ldtr(vt + vrd + 1024), a11 = ldtr(vt + vrd + 1536); \
              const u32x2 b00 = ldtr(vt + vrd + 2048), b01 = ldtr(vt + vrd + 2048 + 512), b10 = ldtr(vt + vrd + 2048 + 1024), b11 = ldtr(vt + vrd + 2048 + 1536); \
              o0 = MFMA32(join8(a00, a01), P0, o0); o0 = MFMA32(join8(a10, a11), P1, o0); \
              o1 = MFMA32(join8(b00, b01), P0, o1); o1 = MFMA32(join8(b10, b11), P1, o1); } \
            LDSO(); \
        } \
        if (kk == 4) DIL_EPI(DIL_RHO(i_) + dl * (DIL_I0(i_) + r32)); } while (0)
#define DIL_EPI(posq_) do { const int posq = (posq_); \
        l = xhalf_sum(l); \
        float inv = 1.f / l; const int pl = posq - t0; \
        float lse = (m + __builtin_amdgcn_logf(l)) * 0.6931471805599453f; \
        LASP unsigned char* orow = obuf + pl * 128 + hi * 32; \
        float wprev = 0.f; \
        if (br > 0) { const float lp = lsebuf[pl]; const float mx = fmx(lp, lse); const float wa = __expf(lp - mx), wb = __expf(lse - mx); const float iv = 1.f / (wa + wb); \
            wprev = wa * iv; inv *= wb * iv; lse = mx + __logf(wa + wb); } \
        float f0[16], f1[16]; \
        _Pragma("unroll") for (int r = 0; r < 16; ++r) { f0[r] = o0[r] * inv; f1[r] = o1[r] * inv; } \
        if (br > 0) { \
            const u32x4 q0 = *(LASP const u32x4*)(orow), q1 = *(LASP const u32x4*)(orow + 16), q2 = *(LASP const u32x4*)(orow + 64), q3 = *(LASP const u32x4*)(orow + 80); \
            const unsigned wa[8] = {q0.x, q0.y, q0.z, q0.w, q1.x, q1.y, q1.z, q1.w}, wb[8] = {q2.x, q2.y, q2.z, q2.w, q3.x, q3.y, q3.z, q3.w}; \
            _Pragma("unroll") for (int i = 0; i < 8; ++i) { f0[2 * i] += wprev * __uint_as_float(wa[i] << 16); f0[2 * i + 1] += wprev * __uint_as_float(wa[i] & 0xffff0000u); \
                f1[2 * i] += wprev * __uint_as_float(wb[i] << 16); f1[2 * i + 1] += wprev * __uint_as_float(wb[i] & 0xffff0000u); } } \
        if (br < 2) { \
            if (hi == 0) lsebuf[pl] = lse; \
            u32x4 w0, w1, w2, w3; \
            w0.x = cvtpk(f0[0], f0[1]); w0.y = cvtpk(f0[2], f0[3]); w0.z = cvtpk(f0[4], f0[5]); w0.w = cvtpk(f0[6], f0[7]); \
            w1.x = cvtpk(f0[8], f0[9]); w1.y = cvtpk(f0[10], f0[11]); w1.z = cvtpk(f0[12], f0[13]); w1.w = cvtpk(f0[14], f0[15]); \
            w2.x = cvtpk(f1[0], f1[1]); w2.y = cvtpk(f1[2], f1[3]); w2.z = cvtpk(f1[4], f1[5]); w2.w = cvtpk(f1[6], f1[7]); \
            w3.x = cvtpk(f1[8], f1[9]); w3.y = cvtpk(f1[10], f1[11]); w3.z = cvtpk(f1[12], f1[13]); w3.w = cvtpk(f1[14], f1[15]); \
            *(LASP u32x4*)(orow) = w0; *(LASP u32x4*)(orow + 16) = w1; *(LASP u32x4*)(orow + 64) = w2; *(LASP u32x4*)(orow + 80) = w3; \
        } else { \
            bf16_t* og = mixed + (size_t)(rb + posq) * DM + 512 + h * 64 + 4 * hi; \
            _Pragma("unroll") for (int g = 0; g < 4; ++g) { u32x2 a, c; a.x = cvtpk(f0[4 * g], f0[4 * g + 1]); a.y = cvtpk(f0[4 * g + 2], f0[4 * g + 3]); c.x = cvtpk(f1[4 * g], f1[4 * g + 1]); c.y = cvtpk(f1[4 * g + 2], f1[4 * g + 3]); \
                *(u32x2*)(og + 8 * g) = a; *(u32x2*)(og + 32 + 8 * g) = c; } } } while (0)
        f32x16 o0 = {}, o1 = {}; float m = -1e30f, l = 0.f;
        DIL_LOADK(K0, 0); DIL_LOADV(V0, 0); DIL_LOADK(K1, 1);
        DIL_QK(s0, K0, 0);
        DIL_STEP(0, s0, s1, K0, K1, V0, V1); DIL_STEP(1, s1, s0, K1, K0, V1, V0); DIL_STEP(2, s0, s1, K0, K1, V0, V1); DIL_STEP(3, s1, s0, K1, K0, V1, V0); DIL_STEP(4, s0, s1, K0, K1, V0, V1);
        DIL_STEP(5, s1, s0, K1, K0, V1, V0); DIL_STEP(6, s0, s1, K0, K1, V0, V1); DIL_STEP(7, s1, s0, K1, K0, V1, V0); DIL_STEP(8, s0, s1, K0, K1, V0, V1); DIL_STEP(9, s1, s0, K1, K0, V1, V0);
#undef DIL_RHO
#undef DIL_I0
#undef DIL_POS
#undef DIL_LOADK
#undef DIL_LOADV
#undef DIL_QK
#undef DIL_STEP
#undef DIL_EPI
        __syncthreads();
    }
}

constexpr int HCOPY_WORDS = 16 * 256 + 8;
template <int NCOPY> __device__ __forceinline__ void find_bin(LASP const unsigned* hist, int lane, unsigned need, unsigned& bin, unsigned& need_in_bin, unsigned& cnt_in_bin) {
    u32x4 h = *(LASP const u32x4*)(hist + 4 * lane);
    if (NCOPY > 1) {
#pragma unroll
        for (int c = 1; c < NCOPY; ++c) h += *(LASP const u32x4*)(hist + c * HCOPY_WORDS + 4 * lane); }
    const unsigned tl = h.x + h.y + h.z + h.w;
    unsigned P = tl;
    P += (unsigned)__builtin_amdgcn_update_dpp(0, (int)P, 0x111, 0xf, 0xf, false);
    P += (unsigned)__builtin_amdgcn_update_dpp(0, (int)P, 0x112, 0xf, 0xf, false);
    P += (unsigned)__builtin_amdgcn_update_dpp(0, (int)P, 0x114, 0xf, 0xf, false);
    P += (unsigned)__builtin_amdgcn_update_dpp(0, (int)P, 0x118, 0xf, 0xf, false);
    P += (unsigned)__builtin_amdgcn_update_dpp(0, (int)P, 0x142, 0xa, 0xf, false);
    P += (unsigned)__builtin_amdgcn_update_dpp(0, (int)P, 0x143, 0xc, 0xf, false);
    const unsigned total = (unsigned)__builtin_amdgcn_readlane((int)P, 63);
    const unsigned above = total - P, suf = above + tl;
    const bool found = (above < need) && (suf >= need);
    const unsigned long long mk = __ballot(found);
    const int fl = __builtin_amdgcn_readfirstlane(mk ? (int)__builtin_ctzll(mk) : 0);
    const unsigned a = (unsigned)__builtin_amdgcn_readlane((int)above, fl), hx = (unsigned)__builtin_amdgcn_readlane((int)h.x, fl), hy = (unsigned)__builtin_amdgcn_readlane((int)h.y, fl), hz = (unsigned)__builtin_amdgcn_readlane((int)h.z, fl), hw = (unsigned)__builtin_amdgcn_readlane((int)h.w, fl);
    unsigned nd = need - a; unsigned bb, cc;
    if (hw >= nd) { bb = 3; cc = hw; } else { nd -= hw; if (hz >= nd) { bb = 2; cc = hz; } else { nd -= hz; if (hy >= nd) { bb = 1; cc = hy; } else { nd -= hy; bb = 0; cc = hx; } } }
    bin = 4 * fl + bb; need_in_bin = nd; cnt_in_bin = cc;
}
typedef unsigned short us2_t __attribute__((ext_vector_type(2)));
__device__ __forceinline__ void sel_row(const u32x4 (&v)[16], LASP const unsigned* hist, LASP unsigned* hist2, unsigned char* bm, int b, int q0, int ql, int wid, int lane, unsigned zz) {
        const int qpos = q0 + ql, nvalid = qpos + 1, nch = (nvalid + 511) >> 9;
        unsigned Tc = 0u, Teq = 0u, rr = 0u; bool ties = false;
        if (nvalid > 256) {
            unsigned bin, need2, cb; find_bin<4>(hist + ql * 256, lane, 256u, bin, need2, cb);
            LASP unsigned* h2 = hist2 + wid * 256;
            *(LASP u32x4*)(h2 + 4 * lane) = (u32x4){zz, zz, zz, zz};
            LDSW();
            const unsigned xb = (bin << 8) | (bin << 24);
#pragma unroll
            for (int c = 0; c < 16; ++c) if (c < nch) {
                unsigned f = 0u;
#pragma unroll
                for (int d = 3; d >= 0; --d) { const unsigned w = d == 0 ? v[c].x : (d == 1 ? v[c].y : (d == 2 ? v[c].z : v[c].w)); const unsigned t = w ^ xb;
                    f = (f << 1) | ((((t - 0x01000100u) & ~t) & 0x80008000u) >> 15); }
                while (f) { const int pb = __builtin_ctz(f); f &= f - 1u; const unsigned d = pb & 3, hf = pb >> 4;
                    const unsigned m1 = 0u - (d & 1u), m2 = 0u - (d >> 1);
                    const unsigned lo_ = (v[c].x & ~m1) | (v[c].y & m1), hi_ = (v[c].z & ~m1) | (v[c].w & m1), w = (lo_ & ~m2) | (hi_ & m2); const unsigned k = (w >> (16u * hf)) & 0xffffu;
                    if ((k >> 8) == bin && 512 * c + 8 * lane + 2 * (int)d + (int)hf <= qpos) __hip_atomic_fetch_add(&h2[k & 255u], 1u, __ATOMIC_RELAXED, __HIP_MEMORY_SCOPE_WORKGROUP); }
            }
            LDSW();
            unsigned tb, r2, ce; find_bin<1>(h2, lane, need2, tb, r2, ce);
            Teq = (bin << 8) | tb;
            if (r2 == ce) { Tc = Teq - 1u; } else { Tc = Teq; ties = true; rr = r2; }
        }
        unsigned tc = 0u; const unsigned Tc2 = Tc | (Tc << 16);
        unsigned char* brow = bm + ((size_t)(b * 256 + (qpos >> 5)) * 256 * 32 + (qpos & 31)) * 4;
#pragma unroll
        for (int c = 0; c < 16; ++c) if (c < nch) {
            int cnt = qpos - (512 * c + 8 * lane) + 1; cnt = cnt < 0 ? 0 : (cnt > 8 ? 8 : cnt);
            const unsigned vm = (1u << cnt) - 1u;
            unsigned acc2 = 0u;
#pragma unroll
            for (int d = 3; d >= 0; --d) { const unsigned w = d == 0 ? v[c].x : (d == 1 ? v[c].y : (d == 2 ? v[c].z : v[c].w)); unsigned df, e;
                asm("v_pk_sub_u16 %0, %1, %2 clamp" : "=v"(df) : "v"(w), "v"(Tc2)); asm("v_pk_min_u16 %0, %1, %2" : "=v"(e) : "v"(df), "v"(0x00010001u));
                acc2 = (acc2 << 2) | e; }
            unsigned byte = (acc2 | (acc2 >> 15)) & 0xffu;
            byte &= vm;
            if (ties) {
                unsigned tieb = 0u;
#pragma unroll
                for (int j = 0; j < 8; ++j) { const unsigned w = (j >> 1) == 0 ? v[c].x : ((j >> 1) == 1 ? v[c].y : ((j >> 1) == 2 ? v[c].z : v[c].w)); const unsigned k = (j & 1) ? (w >> 16) : (w & 0xffffu);
                    tieb |= (k == Teq ? 1u : 0u) << j; }
                tieb &= vm;
                if (__any(tieb != 0u)) {
                    const unsigned nt = __builtin_popcount(tieb);
                    unsigned inc = nt;
#pragma unroll
                    for (int o = 1; o < 64; o <<= 1) { const unsigned t = __shfl_up(inc, o); if (lane >= o) inc += t; }
                    unsigned rank = tc + inc - nt;
#pragma unroll
                    for (int j = 0; j < 8; ++j) if (tieb & (1u << j)) { if (rank < rr) byte |= (1u << j); ++rank; }
                    tc += __shfl(inc, 63);
                }
            }
            { const int bi = 64 * c + lane; brow[(size_t)(bi >> 2) * 128 + (bi & 3)] = (unsigned char)byte; }
        }
}
#define SP_DW(c_, j_) ((j_) < 4 ? ((j_) == 0 ? v[2 * (c_)].x : ((j_) == 1 ? v[2 * (c_)].y : ((j_) == 2 ? v[2 * (c_)].z : v[2 * (c_)].w))) : ((j_) == 4 ? v[2 * (c_) + 1].x : ((j_) == 5 ? v[2 * (c_) + 1].y : ((j_) == 6 ? v[2 * (c_) + 1].z : v[2 * (c_) + 1].w))))
__device__ __forceinline__ void sel_pair(const u32x4 (&v)[32], LASP const unsigned* hist, LASP unsigned* hist2, unsigned char* bm, int b, int q0, int w, int lane, unsigned zz) {
    const int qposA = q0 + 2 * w, qposB = qposA + 1, nvalidA = qposA + 1, nvalidB = qposB + 1, nch = (nvalidB + 511) >> 9;
    unsigned TcA = 0u, TcB = 0u, TeqA = 0u, TeqB = 0u, rrA = 0u, rrB = 0u; bool tiesA = false, tiesB = false;
    if (nvalidB > 256) {
        unsigned binA, need2A, cbA, binB, need2B, cbB;
        find_bin<4>(hist + (2 * w) * 256, lane, 256u, binA, need2A, cbA); find_bin<4>(hist + (2 * w + 1) * 256, lane, 256u, binB, need2B, cbB);
        LASP unsigned* h2 = hist2 + w * 512;
        *(LASP u32x4*)(h2 + 4 * lane) = (u32x4){zz, zz, zz, zz}; *(LASP u32x4*)(h2 + 256 + 4 * lane) = (u32x4){zz, zz, zz, zz};
        LDSW();
        const unsigned xb = (binA << 8) | (binB << 24);
#pragma unroll
        for (int c = 0; c < 16; ++c) if (c < nch) {
            unsigned f = 0u;
#pragma unroll
            for (int j = 7; j >= 0; --j) { const unsigned t = SP_DW(c, j) ^ xb; f = (f << 1) | ((((t - 0x01000100u) & ~t) & 0x80008000u) >> 15); }
            while (f) { const int pb = __builtin_ctz(f); f &= f - 1u; const unsigned j = pb & 7, hf = pb >> 4;
                const unsigned m1 = 0u - (j & 1u), m2 = 0u - ((j >> 1) & 1u), m4 = 0u - (j >> 2);
                const unsigned a0 = (v[2 * c].x & ~m1) | (v[2 * c].y & m1), a1 = (v[2 * c].z & ~m1) | (v[2 * c].w & m1), a2 = (v[2 * c + 1].x & ~m1) | (v[2 * c + 1].y & m1), a3 = (v[2 * c + 1].z & ~m1) | (v[2 * c + 1].w & m1);
                const unsigned b0 = (a0 & ~m2) | (a1 & m2), b1 = (a2 & ~m2) | (a3 & m2), dw = (b0 & ~m4) | (b1 & m4); const unsigned k = (dw >> (16u * hf)) & 0xffffu;
                const unsigned bin = hf ? binB : binA; const int qp = hf ? qposB : qposA;
                if ((k >> 8) == bin && 512 * c + 8 * lane + (int)j <= qp) __hip_atomic_fetch_add(&h2[hf * 256u + (k & 255u)], 1u, __ATOMIC_RELAXED, __HIP_MEMORY_SCOPE_WORKGROUP); }
        }
        LDSW();
        unsigned tbA, r2A, ceA, tbB, r2B, ceB; find_bin<1>(h2, lane, need2A, tbA, r2A, ceA); find_bin<1>(h2 + 256, lane, need2B, tbB, r2B, ceB);
        TeqA = (binA << 8) | tbA; TeqB = (binB << 8) | tbB;
        if (r2A == ceA) { TcA = TeqA - 1u; } else { TcA = TeqA; tiesA = true; rrA = r2A; }
        if (r2B == ceB) { TcB = TeqB - 1u; } else { TcB = TeqB; tiesB = true; rrB = r2B; }
        if (nvalidA <= 256) { TcA = 0u; tiesA = false; }
    }
    unsigned tcA = 0u, tcB = 0u; const unsigned Tc2 = TcA | (TcB << 16);
    unsigned char* brow = bm + ((size_t)(b * 256 + (qposA >> 5)) * 256 * 32 + (qposA & 31)) * 4;
#pragma unroll
    for (int c = 0; c < 16; ++c) if (c < nch) {
        int cntA = qposA - (512 * c + 8 * lane) + 1; cntA = cntA < 0 ? 0 : (cntA > 8 ? 8 : cntA); int cntB = qposB - (512 * c + 8 * lane) + 1; cntB = cntB < 0 ? 0 : (cntB > 8 ? 8 : cntB);
        const unsigned vmA = (1u << cntA) - 1u, vmB = (1u << cntB) - 1u;
        unsigned acc = 0u;
#pragma unroll
        for (int j = 7; j >= 0; --j) { unsigned df, e; asm("v_pk_sub_u16 %0, %1, %2 clamp" : "=v"(df) : "v"(SP_DW(c, j)), "v"(Tc2)); asm("v_pk_min_u16 %0, %1, %2" : "=v"(e) : "v"(df), "v"(0x00010001u)); acc = (acc << 1) | e; }
        unsigned byteA = acc & vmA, byteB = (acc >> 16) & vmB;
        if (tiesA || tiesB) {
#pragma unroll
            for (int hf = 0; hf < 2; ++hf) { const bool ties = hf ? tiesB : tiesA; if (ties) { const unsigned Teq = hf ? TeqB : TeqA, rr = hf ? rrB : rrA, vm = hf ? vmB : vmA; unsigned tc = hf ? tcB : tcA, byte = hf ? byteB : byteA;
                unsigned tieb = 0u;
#pragma unroll
                for (int j = 0; j < 8; ++j) { const unsigned k = (SP_DW(c, j) >> (16 * hf)) & 0xffffu; tieb |= (k == Teq ? 1u : 0u) << j; }
                tieb &= vm;
                if (__any(tieb != 0u)) {
                    const unsigned nt = __builtin_popcount(tieb);
                    unsigned inc = nt;
#pragma unroll
                    for (int o = 1; o < 64; o <<= 1) { const unsigned t = __shfl_up(inc, o); if (lane >= o) inc += t; }
                    unsigned rank = tc + inc - nt;
#pragma unroll
                    for (int j = 0; j < 8; ++j) if (tieb & (1u << j)) { if (rank < rr) byte |= (1u << j); ++rank; }
                    tc += __shfl(inc, 63);
                }
                if (hf) { tcB = tc; byteB = byte; } else { tcA = tc; byteA = byte; } } }
        }
        { const int bi = 64 * c + lane; unsigned char* bp = brow + (size_t)(bi >> 2) * 128 + (bi & 3); bp[0] = (unsigned char)byteA; bp[4] = (unsigned char)byteB; }
    }
}
typedef __fp16 h2_t __attribute__((ext_vector_type(2)));
constexpr int IDX_QST = 100352;
__device__ __forceinline__ void idx_prefetch(LASP unsigned char* qst, const bf16_t* proj, int b, int qt, int wid, int lane) {
#pragma unroll
    for (int i = 0; i < 2; ++i) { const int rho = 16 * wid + 8 * i + (lane >> 3), c = (lane & 7) ^ (rho & 7);
        __builtin_amdgcn_global_load_lds((const unsigned*)(PJ(proj, b * S + qt * 16 + (rho >> 3), C_QI + (rho & 7) * 64) + 8 * c), (LASP unsigned*)(qst + (16 * wid + 8 * i) * 128), 16, 0, 0); }
    if (wid == 0 && lane < 16) __builtin_amdgcn_global_load_lds((const unsigned*)PJ(proj, b * S + qt * 16 + lane, C_WI), (LASP unsigned*)(qst + 16384), 16, 0, 0);
}
__device__ __forceinline__ void idx_item(unsigned char* lds_g, const bf16_t* proj, bf16_t* sc, unsigned char* bm, int b, int qt, int tid, int lane, int wid, int nb, int nqt, bool first) {
    asm volatile("" : "+v"(tid)); lane = tid & 63;
    LASP unsigned char* lds = (LASP unsigned char*)lds_g;
    const int q0 = qt * 16, r32 = lane & 31, hi = lane >> 5;
    LASP unsigned* hist = (LASP unsigned*)lds;
    LASP unsigned* hist2 = hist + 4 * HCOPY_WORDS;
    LASP float* wl = (LASP float*)(hist2 + 8 * 512);
    LASP bf16_t* linA = (LASP bf16_t*)(wl + 128);
    LASP unsigned* stage = (LASP unsigned*)(linA + 16 * 64) + wid * 256;
    LASP unsigned char* qst = lds + IDX_QST;
    const int rb = b * S;
    if (first) { asm volatile("s_waitcnt vmcnt(0)" ::: "memory"); __syncthreads(); }
    bf16x8 A[4][4];
    { const int ql = r32 >> 4, hq = (r32 >> 2) & 1, head = (r32 & 3) + 4 * ((r32 >> 3) & 1);
#pragma unroll
      for (int rt = 0; rt < 4; ++rt) { const int rho = (4 * rt + 2 * hq + ql) * 8 + head;
#pragma unroll
          for (int ks = 0; ks < 4; ++ks) A[rt][ks] = *(LASP const bf16x8*)(qst + rho * 128 + (((2 * ks + hi) ^ (rho & 7)) * 16)); } }
    const int nkt = (q0 + 15) / 32 + 1;
    const bf16_t* kbase = proj + (size_t)(C_KI >> 6) * M * 64 + (size_t)(rb >> 5) * 2048 + (hi * 32 + r32) * 8;
    bf16x8 Ba[4], Bb[4];
#define IDX_LOAD(B_, kt_) do { const bf16_t* kp_ = kbase + (size_t)(kt_) * 2048; _Pragma("unroll") for (int ks = 0; ks < 4; ++ks) B_[ks] = *(const bf16x8*)(kp_ + 512 * ks); } while (0)
    IDX_LOAD(Ba, (wid < nkt) ? wid : (nkt - 1));
    for (int i = tid; i < HCOPY_WORDS; i += 512) *(LASP u32x4*)(hist + 4 * i) = (u32x4){0u, 0u, 0u, 0u};
    {
        const int q = tid >> 5, d2 = 2 * (tid & 31);
        const bf16x8 w8 = *(LASP const bf16x8*)(qst + 16384 + q * 16);
        unsigned qv[8];
#pragma unroll
        for (int hd = 0; hd < 8; ++hd) { const int rho = q * 8 + hd; qv[hd] = *(LASP const unsigned*)(qst + rho * 128 + (((d2 >> 3) ^ (rho & 7)) * 16) + (d2 & 7) * 2); }
        float l0 = 0.f, l1 = 0.f, mine = 0.f;
#pragma unroll
        for (int hd = 0; hd < 8; ++hd) { const float c = bf2f((bf16_t)w8[hd]) * (0.5f * 0.04419417382415922f * (4096.f / 65535.f));
            l0 = fmaf(c, __uint_as_float(qv[hd] << 16), l0); l1 = fmaf(c, __uint_as_float(qv[hd] & 0xffff0000u), l1); mine = ((tid & 31) == hd) ? c : mine; }
        if ((tid & 31) < 8) wl[q * 8 + (tid & 31)] = mine;
        *(LASP unsigned*)(linA + q * 64 + d2) = cvtpk(l0, l1);
    }
    __syncthreads();
    bf16x8 AL[4];
    { const int r = (r32 & 3) + 4 * ((r32 >> 3) & 1), hq = (r32 >> 2) & 1, ql = 4 * (r >> 1) + 2 * hq + (r & 1);
#pragma unroll
      for (int ks = 0; ks < 4; ++ks) { AL[ks] = *(LASP const bf16x8*)(linA + ql * 64 + 16 * ks + 8 * hi); if (r32 >= 16) AL[ks] = (bf16x8){0, 0, 0, 0, 0, 0, 0, 0}; } }
    const unsigned hb = (unsigned)(size_t)(hist + (lane & 3) * HCOPY_WORDS + 2 * hi * 256);
    LASP unsigned* sbase = stage + hi * 32 + r32;
    LASP const float* wbase = wl + 2 * hi * 8;
    unsigned* gst = (unsigned*)sc + (size_t)(lane >> 3) * 8192 + 4 * (lane & 7);
#define IDX_CHAIN(acc_, rt_, B_) do { acc_ = (f32x16){}; _Pragma("unroll") for (int ks = 0; ks < 4; ++ks) acc_ = MFMA32(A[rt_][ks], B_[ks], acc_); } while (0)
#define IDX_EPI(acc_, rt_, EDGE_) do { float s2_[2]; f32x4 cw_[2][2]; \
        _Pragma("unroll") for (int q2 = 0; q2 < 2; ++q2) { cw_[q2][0] = *(LASP const f32x4*)(wbase + (4 * rt_ + q2) * 8); cw_[q2][1] = *(LASP const f32x4*)(wbase + (4 * rt_ + q2) * 8 + 4); }     \
        __builtin_amdgcn_s_waitcnt(0xC07F);     \
        _Pragma("unroll") for (int q2 = 0; q2 < 2; ++q2) { const f32x4 c0 = cw_[q2][0], c1 = cw_[q2][1]; \
            float sv = lin[2 * rt_ + q2]; \
            sv = fmaf(__builtin_fabsf(acc_[8 * q2 + 0]), c0.x, sv); sv = fmaf(__builtin_fabsf(acc_[8 * q2 + 1]), c0.y, sv); sv = fmaf(__builtin_fabsf(acc_[8 * q2 + 2]), c0.z, sv); sv = fmaf(__builtin_fabsf(acc_[8 * q2 + 3]), c0.w, sv); \
            sv = fmaf(__builtin_fabsf(acc_[8 * q2 + 4]), c1.x, sv); sv = fmaf(__builtin_fabsf(acc_[8 * q2 + 5]), c1.y, sv); sv = fmaf(__builtin_fabsf(acc_[8 * q2 + 6]), c1.z, sv); sv = fmaf(__builtin_fabsf(acc_[8 * q2 + 7]), c1.w, sv); s2_[q2] = sv; } \
        us2_t kk2_ = __builtin_amdgcn_cvt_pknorm_u16(s2_[0], s2_[1]); kk2_ = __builtin_elementwise_max(kk2_, (us2_t){1, 1});     \
        const unsigned kk_ = __builtin_bit_cast(unsigned, kk2_); \
        unsigned one0 = 1u, one1 = 1u; if (EDGE_) { one0 = (key <= q0 + 4 * rt_ + 2 * hi) ? 1u : 0u; one1 = (key <= q0 + 4 * rt_ + 2 * hi + 1) ? 1u : 0u; }     \
        __hip_atomic_fetch_add((LASP unsigned*)(hb + (__builtin_amdgcn_ubfe(kk_, 8, 8) << 2)) + (4 * rt_) * 256, one0, __ATOMIC_RELAXED, __HIP_MEMORY_SCOPE_WORKGROUP); \
        __hip_atomic_fetch_add((LASP unsigned*)(hb + ((kk_ >> 24) << 2)) + (4 * rt_ + 1) * 256, one1, __ATOMIC_RELAXED, __HIP_MEMORY_SCOPE_WORKGROUP); \
        sbase[(2 * rt_) * 32] = kk_; } while (0)
#define IDX_COMPUTE_(B_, kt_, EDGE_) do { const int key = 32 * (kt_) + r32; f32x16 ac0, ac1, lin; _Pragma("unroll") for (int e_ = 0; e_ < 16; ++e_) lin[e_] = 0.5f;     \
        _Pragma("unroll") for (int ks = 0; ks < 4; ++ks) lin = MFMA32(AL[ks], B_[ks], lin); \
        IDX_CHAIN(ac0, 0, B_); IDX_CHAIN(ac1, 1, B_); IDX_EPI(ac0, 0, EDGE_); IDX_CHAIN(ac0, 2, B_); IDX_EPI(ac1, 1, EDGE_); IDX_CHAIN(ac1, 3, B_); IDX_EPI(ac0, 2, EDGE_); IDX_EPI(ac1, 3, EDGE_); \
        LDSW(); const u32x4 sv4 = *(LASP const u32x4*)((LASP const unsigned char*)stage + lane * 16); asm volatile("" ::: "memory"); *(u32x4*)(gst + 32 * (kt_)) = sv4; } while (0)
#define IDX_COMPUTE(B_, kt_) do { if (32 * (kt_) + 31 <= q0) IDX_COMPUTE_(B_, kt_, false); else IDX_COMPUTE_(B_, kt_, true); } while (0)
    for (int rm_ = 0; rm_ < RP_IDXMAIN; ++rm_) {
    if (rm_) { __syncthreads(); for (int i = tid; i < 16 * 256; i += 512) hist[i] = 0u; __syncthreads(); }
    if (wid < nkt && wid < IDX_NW) {
        for (int kt = wid; kt < nkt; kt += 2 * IDX_NW) {
            { const int k1 = (kt + IDX_NW < nkt) ? kt + IDX_NW : kt; IDX_LOAD(Bb, k1); }
            IDX_COMPUTE(Ba, kt);
            { const int k2 = (kt + 2 * IDX_NW < nkt) ? kt + 2 * IDX_NW : kt; IDX_LOAD(Ba, k2); }
            if (kt + IDX_NW < nkt) IDX_COMPUTE(Bb, kt + IDX_NW); }
    }
    }
#undef IDX_LOAD
#undef IDX_CHAIN
#undef IDX_EPI
#undef IDX_COMPUTE
#undef IDX_COMPUTE_
    __syncthreads();
    if (nqt >= 0) idx_prefetch(qst, proj, nb, nqt, wid, lane);
    {
        u32x4 v[32];
        unsigned zz = 0u; asm volatile("" : "+v"(zz));
        const int nch = (q0 + 2 * wid + 2 + 511) >> 9;
        const unsigned* rowp = (const unsigned*)sc + (size_t)wid * 8192 + lane * 8;
#pragma unroll
        for (int c = 0; c < 16; ++c) { if (c < nch) { v[2 * c] = *(const u32x4*)(rowp + 512 * c); v[2 * c + 1] = *(const u32x4*)(rowp + 512 * c + 4); } else { v[2 * c] = (u32x4){zz, zz, zz, zz}; v[2 * c + 1] = v[2 * c]; } }
        sel_pair(v, hist, hist2, bm, b, q0, wid, lane, zz);
    }
    asm volatile("s_waitcnt vmcnt(0)" ::: "memory");
    __syncthreads();
}

__device__ __forceinline__ void dsa_kv_item(unsigned char* lds, const bf16_t* proj, const float* nw, const bf16_t* wkv, bf16_t* Kd, bf16_t* VT, int item, int lane, int wid) {
    bf16_t* cb = (bf16_t*)lds;
    const int tok0 = item * 64, b = tok0 / S, r32 = lane & 31, hi = lane >> 5;
    {
        unsigned pv[8]; float ss[8];
#pragma unroll
        for (int rr = 0; rr < 8; ++rr) pv[rr] = *(const unsigned*)(PJ(proj, tok0 + 8 * wid + rr, C_CKV + 2 * lane));
        const float n0 = nw[2 * lane], n1 = nw[2 * lane + 1];
#pragma unroll
        for (int rr = 0; rr < 8; ++rr) { const float f0 = __uint_as_float(pv[rr] << 16), f1 = __uint_as_float(pv[rr] & 0xffff0000u); ss[rr] = f0 * f0 + f1 * f1; }
#pragma unroll
        for (int rr = 0; rr < 8; ++rr) ss[rr] = wave_allsum(ss[rr]);
#pragma unroll
        for (int rr = 0; rr < 8; ++rr) { const float f0 = __uint_as_float(pv[rr] << 16), f1 = __uint_as_float(pv[rr] & 0xffff0000u); const float rstd = rsqrtf(ss[rr] * (1.f / 128.f) + NORM_EPS);
            *(unsigned*)(cb + (8 * wid + rr) * 136 + 2 * lane) = cvtpk(f0 * rstd * n0, f1 * rstd * n1); }
    }
    __syncthreads();
    bf16x8 Wa[8], Wb[8];
#define DKV_LOADW(W_, tile_) do { const int id_ = (tile_) & 15, nt_ = id_ >> 1; const bf16_t* wp_ = wkv + (size_t)((((tile_) >= 16) ? 256 : 0) + 32 * nt_ + r32) * 128 + 8 * hi; \
        _Pragma("unroll") for (int ks = 0; ks < 8; ++ks) W_[ks] = *(const bf16x8*)(wp_ + 16 * ks); } while (0)
#define DKV_TILE(W_, tile_) do { const int id = (tile_) & 15, tt = id & 1, nt = id >> 1; const bool isv = (tile_) >= 16; \
          \
        const bf16_t* ap = cb + (32 * tt + r32) * 136 + 8 * hi; f32x16 acc = {}; \
        _Pragma("unroll") for (int ks = 0; ks < 8; ++ks) { const bf16x8 a = *(const bf16x8*)(ap + 16 * ks); acc = isv ? MFMA32(a, W_[ks], acc) : MFMA32(W_[ks], a, acc); } \
        if (!isv) {     \
            bf16_t* kt_ = Kd + ((size_t)(b * 4 + (nt >> 1)) * 256 + (((tok0 - b * S) >> 5) + tt)) * 2048; \
            _Pragma("unroll") for (int g = 0; g < 4; ++g) { u32x2 o; o.x = cvtpk(acc[4 * g], acc[4 * g + 1]); o.y = cvtpk(acc[4 * g + 2], acc[4 * g + 3]); \
                *(u32x2*)(kt_ + ((4 * (nt & 1) + g) * 32 + r32) * 8 + 4 * hi) = o; } \
        } else {        \
            const int n = 32 * nt + r32, d = n & 63; bf16_t* vt_ = VT + ((size_t)(b * 4 + (n >> 6)) * 256 + (((tok0 - b * S) >> 5) + tt)) * 2048; \
            _Pragma("unroll") for (int t2 = 0; t2 < 2; ++t2) { u32x4 o; o.x = cvtpk(acc[8 * t2], acc[8 * t2 + 1]); o.y = cvtpk(acc[8 * t2 + 2], acc[8 * t2 + 3]); o.z = cvtpk(acc[8 * t2 + 4], acc[8 * t2 + 5]); o.w = cvtpk(acc[8 * t2 + 6], acc[8 * t2 + 7]); \
                *(u32x4*)(vt_ + ((((d >> 5) * 2 + t2) * 2 + hi) * 32 + (d & 31)) * 8) = o; } \
        } } while (0)
    DKV_LOADW(Wa, 2 * wid); DKV_LOADW(Wb, 16 + 2 * wid);
    DKV_TILE(Wa, 2 * wid); DKV_TILE(Wa, 2 * wid + 1);
    DKV_TILE(Wb, 16 + 2 * wid); DKV_TILE(Wb, 16 + 2 * wid + 1);
#undef DKV_LOADW
#undef DKV_TILE
    __syncthreads();
}

template <int MODE>
__device__ __forceinline__ void dsa_att_wave(const bf16_t* proj, const bf16_t* KH, const bf16_t* VTT, const unsigned* bm32, bf16_t* mixed, int b, int h, int q0, int kt0, int kt1, LASP float* pbuf, int lane) {
    const int r32 = lane & 31, hi = lane >> 5;
    const bf16_t* qp = PJ(proj, b * S + q0 + r32, C_DQ + h * 64) + 8 * hi;
    constexpr float C2 = 0.125f * 1.4426950408889634f;
    bf16x8 Qf[4];
#pragma unroll
    for (int ks = 0; ks < 4; ++ks) { const bf16x8 q_ = *(const bf16x8*)(qp + 16 * ks); float f_[8];
#pragma unroll
        for (int e = 0; e < 8; ++e) f_[e] = bf2f((bf16_t)q_[e]) * C2;
        Qf[ks] = pack8h(f_); }
    const bf16_t* kbase = KH + (size_t)(b * 4 + h) * 256 * 2048 + (hi * 32 + r32) * 8;
    const bf16_t* vbase = VTT + (size_t)(b * 4 + h) * 256 * 2048 + (hi * 32 + r32) * 8;
    const unsigned* mrow = bm32 + (size_t)(b * 256 + (q0 >> 5)) * 256 * 32 + r32;
    f32x16 o0 = {}, o1 = {}, minit = {}; float mc = 0.f, l = 0.f, pend = 0.f;
    bf16x8 Ka[4], Kb[4], Va[4], Vb[4]; unsigned Wa, Wb; f32x16 sa, sb;
    const bf16x8 ONES = {(short)0x3f80, (short)0x3f80, (short)0x3f80, (short)0x3f80, (short)0x3f80, (short)0x3f80, (short)0x3f80, (short)0x3f80};
#define DSA_LOADK(K_, kt_) do { const bf16_t* kp_ = kbase + (size_t)(kt_) * 2048; _Pragma("unroll") for (int ks = 0; ks < 4; ++ks) K_[ks] = *(const bf16x8*)(kp_ + 512 * ks); } while (0)
#define DSA_LOADV(V_, W_, kt_) do { const bf16_t* vp_ = vbase + (size_t)(kt_) * 2048; V_[0] = *(const bf16x8*)(vp_); V_[1] = *(const bf16x8*)(vp_ + 512); V_[2] = *(const bf16x8*)(vp_ + 1024); V_[3] = *(const bf16x8*)(vp_ + 1536); W_ = mrow[(kt_) * 32]; } while (0)
#define DSA_QK(s_, K_) do { s_ = MFMA32(K_[0], Qf[0], minit); _Pragma("unroll") for (int ks = 1; ks < 4; ++ks) s_ = MFMA32(K_[ks], Qf[ks], s_); } while (0)
#define DSA_SMPV(s_, V_, W_) do { \
        float tmax = fmx(fmx(s_[0], s_[1]), fmx(s_[2], s_[3])); \
        _Pragma("unroll") for (int r = 4; r < 16; r += 4) tmax = fmx(tmax, fmx(fmx(s_[r], s_[r + 1]), fmx(s_[r + 2], s_[r + 3]))); \
        tmax = xhalf_max(tmax); \
        const float d_ = pend, tm_ = tmax + d_; \
        if (__any((tm_ > 6.f) || (d_ != 0.f))) {     \
            float sh_ = d_; pend = 0.f; \
            if (__any(tm_ > 6.f)) { const float inc = fmx(tm_, 0.f), alpha = __builtin_amdgcn_exp2f(-inc); o0 = o0 * alpha; o1 = o1 * alpha; l *= alpha; mc += inc; sh_ -= inc; pend = -inc; \
                _Pragma("unroll") for (int r = 0; r < 16; ++r) minit[r] = -mc; } \
            _Pragma("unroll") for (int r = 0; r < 16; ++r) s_[r] += sh_; } \
        const int Ws = (int)((W_) >> (4 * hi)); float p[16]; \
        _Pragma("unroll") for (int r = 0; r < 16; ++r) { const float e = __builtin_amdgcn_exp2f(s_[r]); int mk = __builtin_amdgcn_sbfe(Ws, (r & 3) + 8 * (r >> 2), 1); \
            asm volatile("" : "+v"(mk));     \
            p[r] = __uint_as_float(__float_as_uint(e) & (unsigned)mk); } \
        l += ((p[0] + p[1]) + (p[2] + p[3])) + ((p[4] + p[5]) + (p[6] + p[7])) + (((p[8] + p[9]) + (p[10] + p[11])) + ((p[12] + p[13]) + (p[14] + p[15]))); \
        const bf16x8 P0 = pack8h(p), P1 = pack8h(p + 8); \
        o0 = MFMA32(V_[0], P0, o0); o1 = MFMA32(V_[2], P0, o1); o0 = MFMA32(V_[1], P1, o0); o1 = MFMA32(V_[3], P1, o1); \
        } while (0)
    if (kt0 < kt1) {
        const int lastt = kt1 - 1;
#define DSA_CL(k_) ((k_) < kt1 ? (k_) : lastt)
        DSA_LOADK(Ka, kt0); DSA_LOADV(Va, Wa, kt0); DSA_LOADK(Kb, DSA_CL(kt0 + 1));
        DSA_QK(sa, Ka);
        for (int kt = kt0; kt < kt1; kt += 2) {
            DSA_LOADK(Ka, DSA_CL(kt + 2)); DSA_LOADV(Vb, Wb, DSA_CL(kt + 1));
            DSA_QK(sb, Kb);
            DSA_SMPV(sa, Va, Wa);
            if (kt + 1 < kt1) {
                DSA_LOADK(Kb, DSA_CL(kt + 3)); DSA_LOADV(Va, Wa, DSA_CL(kt + 2));
                DSA_QK(sa, Ka);
                DSA_SMPV(sb, Vb, Wb);
            }
        }
#undef DSA_CL
    }
#undef DSA_LOADK
#undef DSA_LOADV
#undef DSA_QK
#undef DSA_SMPV

    if (MODE == 1) {
#pragma unroll
        for (int r = 0; r < 16; ++r) { pbuf[r * 64 + lane] = o0[r]; pbuf[(16 + r) * 64 + lane] = o1[r]; }
        pbuf[32 * 64 + lane] = mc; pbuf[33 * 64 + lane] = l;
    }
    if (MODE != 0) __syncthreads();
    if (MODE == 1) return;
    if (MODE == 2) {
        const float mb = pbuf[32 * 64 + lane], lb = pbuf[33 * 64 + lane];
        const float mn = fmx(mc, mb), fa = __builtin_amdgcn_exp2f(mc - mn), fb = __builtin_amdgcn_exp2f(mb - mn);
        l = l * fa + lb * fb;
#pragma unroll
        for (int r = 0; r < 16; ++r) { o0[r] = o0[r] * fa + pbuf[r * 64 + lane] * fb; o1[r] = o1[r] * fa + pbuf[(16 + r) * 64 + lane] * fb; }
    }
    l = xhalf_sum(l);
    const float inv = 1.f / l;
    bf16_t* orow = mixed + (size_t)(b * S + q0 + r32) * DM + 256 + h * 64 + 4 * hi;
#pragma unroll
    for (int g = 0; g < 4; ++g) { u32x2 a, c; a.x = cvtpk(o0[4 * g] * inv, o0[4 * g + 1] * inv); a.y = cvtpk(o0[4 * g + 2] * inv, o0[4 * g + 3] * inv);
        c.x = cvtpk(o1[4 * g] * inv, o1[4 * g + 1] * inv); c.y = cvtpk(o1[4 * g + 2] * inv, o1[4 * g + 3] * inv);
        *(u32x2*)(orow + 8 * g) = a; *(u32x2*)(orow + 32 + 8 * g) = c; }
}

__device__ __forceinline__ void rot8(int pos, int i0, float* c, float* s) {
#pragma unroll
    for (int e = 0; e < 8; ++e) { const float inv = __builtin_amdgcn_exp2f(-(float)(i0 + e) * (13.287712379549449f / 32.f));
        float t = ((float)pos * inv) * 0.15915494309189535f; t = t - floorf(t); s[e] = __builtin_amdgcn_sinf(t); c[e] = __builtin_amdgcn_cosf(t); }
}
struct RkvLoads { bf16x8 a, bb, v0, v1; };
__device__ __forceinline__ RkvLoads ret_kv_load(const bf16_t* proj, int item, int tid) {
    const int b = item >> 8, h = (item >> 6) & 3, n = item & 63, tok0 = b * S + n * 128;
    const int j = tid >> 2, c4 = tid & 3; const bf16_t* p = PJ(proj, tok0 + j, C_RK + h * 64);
    RkvLoads L; L.a = *(const bf16x8*)(p + 8 * c4); L.bb = *(const bf16x8*)(p + 32 + 8 * c4);
    L.v0 = *(const bf16x8*)(PJ(proj, tok0 + (tid >> 3), C_RV + h * 64) + 8 * (tid & 7)); L.v1 = *(const bf16x8*)(PJ(proj, tok0 + ((tid + 512) >> 3), C_RV + h * 64) + 8 * (tid & 7));
    return L;
}
__device__ __forceinline__ void ret_kv_images(LASP unsigned char* lds, int off, const RkvLoads& L, int item, int tid) {
    const int h = (item >> 6) & 3, n = item & 63;
    LASP unsigned char* Kimg = lds + off; LASP unsigned char* Vimg = lds + off + 16384;
    const float lg = log2_gamma(h);
    {
        const int j = tid >> 2, c4 = tid & 3;
        float cs[8], sn[8]; rot8(n * 128 + j, 8 * c4, cs, sn);
        const float z = 0.125f * __builtin_amdgcn_exp2f((float)(127 - j) * lg);
        float y1[8], y2[8];
#pragma unroll
        for (int e = 0; e < 8; ++e) { const float x1 = bf2f((bf16_t)L.a[e]), x2 = bf2f((bf16_t)L.bb[e]); y1[e] = (x1 * cs[e] - x2 * sn[e]) * z; y2[e] = (x2 * cs[e] + x1 * sn[e]) * z; }
        LASP unsigned char* dst = Kimg + (j >> 5) * 4096 + (j & 31) * 64 + c4 * 16;
        *(LASP bf16x8*)(dst) = pack8h(y1); *(LASP bf16x8*)(dst + 2048) = pack8h(y2);
    }
#pragma unroll
    for (int it = 0; it < 2; ++it) { const int idx = tid + 512 * it, j = idx >> 3, c8 = idx & 7;
        *(LASP bf16x8*)(Vimg + (j >> 5) * 4096 + (c8 >> 2) * 2048 + (j & 31) * 64 + (c8 & 3) * 16) = it ? L.v1 : L.v0; }
}
__device__ __forceinline__ void ret_kv_mma(LASP unsigned char* lds, int off, float* KVT, int item, int w4, int lane) {
    const int r32 = lane & 31, hi = lane >> 5, et = w4 >> 1, dt = w4 & 1;
    LASP unsigned char* Kimg = lds + off; LASP unsigned char* Vimg = lds + off + 16384;
    const int vrd = (4 * hi + ((lane & 15) >> 2)) * 64 + (16 * ((lane >> 4) & 1) + 4 * (lane & 3)) * 2;
    f32x16 acc = {};
#pragma unroll
    for (int st = 0; st < 4; ++st)
#pragma unroll
        for (int t = 0; t < 2; ++t) {
            LASP const unsigned char* va = Vimg + st * 4096 + et * 2048 + vrd + t * 1024; LASP const unsigned char* ka = Kimg + st * 4096 + dt * 2048 + vrd + t * 1024;
            const u32x2 a0 = ldtr(va), a1 = ldtr(va + 512), b0 = ldtr(ka), b1 = ldtr(ka + 512);
            acc = MFMA32(join8(b0, b1), join8(a0, a1), acc);
        }
    bf16_t* o = (bf16_t*)KVT + (size_t)item * 4096 + (32 * et + r32) * 64 + 32 * dt + 4 * hi;
#pragma unroll
    for (int g = 0; g < 4; ++g) { u32x2 w; w.x = cvtpk(acc[4 * g], acc[4 * g + 1]); w.y = cvtpk(acc[4 * g + 2], acc[4 * g + 3]); *(u32x2*)(o + 8 * g) = w; }
}
__device__ __forceinline__ void ret_out_item(unsigned char* lds_g, const bf16_t* proj, const float* KVT, const float* rnw, bf16_t* mixed, int item, int tid, int lane, int wid, f32x4& cy0, f32x4& cy1, int& cyn) {
    LASP unsigned char* lds = (LASP unsigned char*)lds_g;
    const int b = item >> 8, h = (item >> 6) & 3, n = item & 63, tok0 = b * S + n * 128, r32 = lane & 31, hi = lane >> 5;
    LASP bf16_t* Qb = (LASP bf16_t*)lds; LASP bf16_t* Kb = Qb + 128 * 72; LASP unsigned char* Vimg = (LASP unsigned char*)(Kb + 128 * 72); LASP bf16_t* St = (LASP bf16_t*)(Vimg + 16384);
    const float lg = log2_gamma(h);
    {
        const int j = tid >> 2, c4 = tid & 3;
        const bf16_t* pq = PJ(proj, tok0 + j, C_RQ + h * 64); const bf16_t* pk = PJ(proj, tok0 + j, C_RK + h * 64);
        const bf16x8 qa = *(const bf16x8*)(pq + 8 * c4), qb = *(const bf16x8*)(pq + 32 + 8 * c4), ka = *(const bf16x8*)(pk + 8 * c4), kb = *(const bf16x8*)(pk + 32 + 8 * c4);
        const int j0 = tid >> 3, j1 = (tid + 512) >> 3, c8 = tid & 7;
        const bf16x8 v0 = *(const bf16x8*)(PJ(proj, tok0 + j0, C_RV + h * 64) + 8 * c8), v1 = *(const bf16x8*)(PJ(proj, tok0 + j1, C_RV + h * 64) + 8 * c8);
        float cs[8], sn[8]; rot8(n * 128 + j, 8 * c4, cs, sn);
        float y1[8], y2[8];
#pragma unroll
        for (int e = 0; e < 8; ++e) { const float x1 = bf2f((bf16_t)qa[e]), x2 = bf2f((bf16_t)qb[e]); y1[e] = x1 * cs[e] - x2 * sn[e]; y2[e] = x2 * cs[e] + x1 * sn[e]; }
        *(LASP bf16x8*)(Qb + j * 72 + 8 * c4) = pack8h(y1); *(LASP bf16x8*)(Qb + j * 72 + 32 + 8 * c4) = pack8h(y2);
#pragma unroll
        for (int e = 0; e < 8; ++e) { const float x1 = bf2f((bf16_t)ka[e]), x2 = bf2f((bf16_t)kb[e]); y1[e] = (x1 * cs[e] - x2 * sn[e]) * 0.125f; y2[e] = (x2 * cs[e] + x1 * sn[e]) * 0.125f; }
        *(LASP bf16x8*)(Kb + j * 72 + 8 * c4) = pack8h(y1); *(LASP bf16x8*)(Kb + j * 72 + 32 + 8 * c4) = pack8h(y2);
        *(LASP bf16x8*)(Vimg + (j0 >> 5) * 4096 + (c8 >> 2) * 2048 + (j0 & 31) * 64 + (c8 & 3) * 16) = v0;
        *(LASP bf16x8*)(Vimg + (j1 >> 5) * 4096 + (c8 >> 2) * 2048 + (j1 & 31) * 64 + (c8 & 3) * 16) = v1;
    }
    {
        const float g = exp2f(128.f * lg); float w = 1.f; f32x4 a0 = {0.f, 0.f, 0.f, 0.f}, a1 = {0.f, 0.f, 0.f, 0.f};
        const bool cont = (cyn >= 0) && (cyn <= n); const int lo = cont ? cyn : 0;
        if (cont) { const float sc = exp2f(128.f * lg * (float)(n - cyn)); a0 = cy0 * sc; a1 = cy1 * sc; }
        const bf16_t* kp = (const bf16_t*)KVT + (size_t)(item - n) * 4096 + 8 * tid;
        for (int mm = n - 1; mm >= lo; mm -= 8) {
            u32x4 u[8];
#pragma unroll
            for (int i = 0; i < 8; ++i) { const int mi = (mm - i) >= lo ? (mm - i) : lo; u[i] = *(const u32x4*)(kp + (size_t)mi * 4096); }
#pragma unroll
            for (int i = 0; i < 8; ++i) { const float wi = (mm - i) >= lo ? w : 0.f;
                a0.x = fmaf(__uint_as_float(u[i].x << 16), wi, a0.x); a0.y = fmaf(__uint_as_float(u[i].x & 0xffff0000u), wi, a0.y); a0.z = fmaf(__uint_as_float(u[i].y << 16), wi, a0.z); a0.w = fmaf(__uint_as_float(u[i].y & 0xffff0000u), wi, a0.w);
                a1.x = fmaf(__uint_as_float(u[i].z << 16), wi, a1.x); a1.y = fmaf(__uint_as_float(u[i].z & 0xffff0000u), wi, a1.y); a1.z = fmaf(__uint_as_float(u[i].w << 16), wi, a1.z); a1.w = fmaf(__uint_as_float(u[i].w & 0xffff0000u), wi, a1.w);
                w *= g; }
        }
        cy0 = a0; cy1 = a1; cyn = n;
        const int e = (8 * tid) >> 6, d0 = (8 * tid) & 63;
        u32x4 o; o.x = cvtpk(a0.x, a0.y); o.y = cvtpk(a0.z, a0.w); o.z = cvtpk(a1.x, a1.y); o.w = cvtpk(a1.z, a1.w);
        *(LASP u32x4*)(St + e * 72 + d0) = o;
    }
    __syncthreads();
    if (wid < 4) {
        const int cs = wid, c = 32 * cs + r32;
        u32x2 ggv[4][2]; f32x4 wwv[4][2];
        { const bf16_t* gp_ = PJ(proj, tok0 + c, C_RG + h * 64) + 4 * hi; const float* wn_ = rnw + h * 64 + 4 * hi;
#pragma unroll
          for (int g = 0; g < 4; ++g)
#pragma unroll
              for (int dt = 0; dt < 2; ++dt) { ggv[g][dt] = *(const u32x2*)(gp_ + 32 * dt + 8 * g); wwv[g][dt] = *(const f32x4*)(wn_ + 32 * dt + 8 * g); } }
        const int vrd = (4 * hi + ((lane & 15) >> 2)) * 64 + (16 * ((lane >> 4) & 1) + 4 * (lane & 3)) * 2;
        bf16x8 Qf[4];
#pragma unroll
        for (int ks = 0; ks < 4; ++ks) Qf[ks] = *(LASP const bf16x8*)(Qb + (32 * cs + r32) * 72 + 16 * ks + 8 * hi);
        f32x16 x0 = {}, x1 = {}, o0 = {}, o1 = {};
#pragma unroll
        for (int ks = 0; ks < 4; ++ks) { x0 = MFMA32(*(LASP const bf16x8*)(St + (r32) * 72 + 16 * ks + 8 * hi), Qf[ks], x0); x1 = MFMA32(*(LASP const bf16x8*)(St + (32 + r32) * 72 + 16 * ks + 8 * hi), Qf[ks], x1); }
        for (int ms = 0; ms <= cs; ++ms) {
            f32x16 s = {};
#pragma unroll
            for (int ks = 0; ks < 4; ++ks) s = MFMA32(*(LASP const bf16x8*)(Kb + (32 * ms + r32) * 72 + 16 * ks + 8 * hi), Qf[ks], s);
            float p[16];
#pragma unroll
            for (int r = 0; r < 16; ++r) { const int dlt = c - (32 * ms + crow(r, hi)); p[r] = (dlt >= 0) ? s[r] * __builtin_amdgcn_exp2f((float)dlt * lg) : 0.f; }
            const bf16x8 P0 = pack8h(p), P1 = pack8h(p + 8);
            LASP const unsigned char* vt = Vimg + ms * 4096 + vrd;
            const u32x2 a00 = ldtr(vt), a01 = ldtr(vt + 512), a10 = ldtr(vt + 1024), a11 = ldtr(vt + 1536);
            const u32x2 b00 = ldtr(vt + 2048), b01 = ldtr(vt + 2048 + 512), b10 = ldtr(vt + 2048 + 1024), b11 = ldtr(vt + 2048 + 1536);
            o0 = MFMA32(join8(a00, a01), P0, o0); o0 = MFMA32(join8(a10, a11), P1, o0);
            o1 = MFMA32(join8(b00, b01), P0, o1); o1 = MFMA32(join8(b10, b11), P1, o1);
        }
        const float xi = __builtin_amdgcn_exp2f((float)(c + 1) * lg);
        o0 = o0 + x0 * xi; o1 = o1 + x1 * xi;
        float sm = 0.f;
#pragma unroll
        for (int r = 0; r < 16; ++r) sm += o0[r] + o1[r];
        sm = xhalf_sum(sm); const float mean = sm * (1.f / 64.f);
        float vs = 0.f;
#pragma unroll
        for (int r = 0; r < 16; ++r) { const float d0 = o0[r] - mean, d1 = o1[r] - mean; vs += d0 * d0 + d1 * d1; }
        vs = xhalf_sum(vs); const float rstd = rsqrtf(vs * (1.f / 64.f) + NORM_EPS);
        bf16_t* orow = mixed + (size_t)(tok0 + c) * DM + h * 64 + 4 * hi;
#pragma unroll
        for (int g = 0; g < 4; ++g) {
#pragma unroll
            for (int dt = 0; dt < 2; ++dt) { const u32x2 gg = ggv[g][dt]; const f32x4 ww = wwv[g][dt];
                const float gv[4] = {__uint_as_float(gg.x << 16), __uint_as_float(gg.x & 0xffff0000u), __uint_as_float(gg.y << 16), __uint_as_float(gg.y & 0xffff0000u)};
                const float wv[4] = {ww.x, ww.y, ww.z, ww.w}; float y[4];
#pragma unroll
                for (int e = 0; e < 4; ++e) { const float ov = dt ? o1[4 * g + e] : o0[4 * g + e]; const float yy = (ov - mean) * rstd * wv[e]; y[e] = yy * gv[e] / (1.f + __expf(-gv[e])); }
                u32x2 ow; ow.x = cvtpk(y[0], y[1]); ow.y = cvtpk(y[2], y[3]); *(u32x2*)(orow + 32 * dt + 8 * g) = ow; } }
    }
    __syncthreads();
}
__device__ __forceinline__ void zero_cols(bf16_t* mixed, int col0, int ncols, int gtid, int gthreads) {
    const int per = ncols / 8; const size_t tot = (size_t)M * per;
    for (size_t i = gtid; i < tot; i += gthreads) { const size_t row = i / per; const int c = (int)(i % per); *(u32x4*)(mixed + row * DM + col0 + 8 * c) = (u32x4){0u, 0u, 0u, 0u}; }
}

#define GAS __attribute__((address_space(1)))
#define LAS __attribute__((address_space(3)))
typedef GAS unsigned gu32;
typedef GAS unsigned long long gu64;
#define RLX_AGENT __ATOMIC_RELAXED, __HIP_MEMORY_SCOPE_AGENT
#define LDS_WAIT() asm volatile("s_waitcnt lgkmcnt(0)" ::: "memory")
#define VM_WAIT() asm volatile("s_waitcnt vmcnt(0)" ::: "memory")

#define XB_TMO      128
#define XB_XCNT(j)  (256  + 64 * (j))
#define XB_XSUB(j)  (1280 + 64 * (j))
#define XB_XGEN(j)  (2304 + 64 * (j))
#define XB_TOP      3328
#define XB_TOPGEN   3392
#define XCD_BAR_WORDS 3456
#define XB_SPIN_CAP (1u << 18)

__device__ __forceinline__ unsigned xb_ld(unsigned* p)              { return __hip_atomic_load(p, __ATOMIC_RELAXED, __HIP_MEMORY_SCOPE_AGENT); }
__device__ __forceinline__ unsigned xb_add(unsigned* p, unsigned v) { return __hip_atomic_fetch_add(p, v, __ATOMIC_RELAXED, __HIP_MEMORY_SCOPE_AGENT); }
__device__ __forceinline__ unsigned xb_xcc_id() { return (unsigned)__builtin_amdgcn_s_getreg((3 << 11) | 20) & 0xFu; }
#define XB_SPIN(cond, bar) do { unsigned _sp = 0; while (cond) { __builtin_amdgcn_s_sleep(1); \
    if ((++_sp & 255u) == 0u) { if (xb_ld(&(bar)[XB_TMO])) break; if (_sp > XB_SPIN_CAP) { atomicAdd(&(bar)[XB_TMO], 1u); break; } } } } while (0)

struct XcdBarrier {
    unsigned* bar; unsigned x;
    volatile LAS unsigned* st;
};

__device__ __forceinline__ XcdBarrier xcd_barrier_post(unsigned* bar, volatile LAS unsigned* st) {
    XcdBarrier b; b.bar = bar; b.x = xb_xcc_id(); b.st = st;
    if (threadIdx.x == 0) (void)xb_add(&bar[XB_XCNT(b.x)], 1u);
    return b;
}
__device__ __forceinline__ void xcd_barrier_complete(unsigned* bar, unsigned x, unsigned& nloc, unsigned& nx) {
    const unsigned G = gridDim.x * gridDim.y * gridDim.z;
    unsigned sum, cnt, mine, sp = 0u;
    for (;;) {
        sum = 0u; cnt = 0u; mine = 0u;
#pragma unroll
        for (unsigned j = 0; j < 16; ++j) { const unsigned c = xb_ld(&bar[XB_XCNT(j)]); sum += c; cnt += (c > 0u) ? 1u : 0u; mine = (j == x) ? c : mine; }
        if (sum == G) break;
        __builtin_amdgcn_s_sleep(1);
        if ((++sp & 255u) == 0u) { if (xb_ld(&bar[XB_TMO])) break; if (sp > XB_SPIN_CAP) { atomicAdd(&bar[XB_TMO], 1u); break; } }
    }
    nloc = mine > 0u ? mine : 1u; nx = cnt > 0u ? cnt : 1u;
}

__device__ __forceinline__ void xcd_barrier(const XcdBarrier& b) {
    asm volatile("s_waitcnt vmcnt(0)" ::: "memory");
    __syncthreads();
    if (threadIdx.x == 0) {
        unsigned* bar = b.bar;
        __builtin_amdgcn_s_waitcnt(0);
        unsigned nloc = b.st[0], nx = b.st[1];
        if (nloc == 0u) { xcd_barrier_complete(bar, b.x, nloc, nx); b.st[0] = nloc; b.st[1] = nx; }
        const unsigned old = xb_add(&bar[XB_XSUB(b.x)], 1u);
        const unsigned gen = old / nloc;
        if (old + 1u == (gen + 1u) * nloc) {
            __builtin_amdgcn_fence(__ATOMIC_RELEASE, "agent");
            asm volatile("s_waitcnt vmcnt(0)" ::: "memory");
            const unsigned og = xb_add(&bar[XB_TOP], 1u);
            const unsigned tg = og / nx;
            if (og + 1u == (tg + 1u) * nx) xb_add(&bar[XB_TOPGEN], 1u);
            else XB_SPIN(xb_ld(&bar[XB_TOPGEN]) == tg, bar);
            __builtin_amdgcn_fence(__ATOMIC_ACQUIRE, "agent");
            xb_add(&bar[XB_XGEN(b.x)], 1u);
            asm volatile("s_waitcnt vmcnt(0)" ::: "memory");
        } else {
            XB_SPIN(xb_ld(&bar[XB_XGEN(b.x)]) == gen, bar);
            __builtin_amdgcn_fence(__ATOMIC_ACQUIRE, "agent");
            asm volatile("s_waitcnt vmcnt(0)" ::: "memory");
        }
    }
    __syncthreads();
}


__device__ __forceinline__ void team_barrier(unsigned* ctr, unsigned* bar, volatile LAS unsigned* same_xcd) {
    asm volatile("s_waitcnt vmcnt(0)" ::: "memory");
    __syncthreads();
    if (threadIdx.x == 0) {
        __builtin_amdgcn_s_waitcnt(0);
        if (*same_xcd == 0u) {
            __builtin_amdgcn_fence(__ATOMIC_RELEASE, "agent");
            asm volatile("s_waitcnt vmcnt(0)" ::: "memory"); }
        (void)xb_add(ctr, 1u);
        XB_SPIN(xb_ld(ctr) < 4u, bar);
        __builtin_amdgcn_fence(__ATOMIC_ACQUIRE, "agent");
        asm volatile("s_waitcnt vmcnt(0)" ::: "memory");
    }
    __syncthreads();
}
constexpr size_t WS_XTAB = 900 * 1024;
constexpr size_t WS_TEAM = 768 * 1024;

struct Params { const float* in[12]; float* out; unsigned char* ws; };
__global__ void __launch_bounds__(512, 2) hymba_fwd(Params p) {
    extern __shared__ __attribute__((aligned(16))) unsigned char lds[];
    cg::grid_group grid = cg::this_grid();
    for (int u = threadIdx.x; u < (LDS_BYTES - 131072) / 4; u += 512) ((__attribute__((address_space(3))) unsigned*)((__attribute__((address_space(3))) unsigned char*)lds + 131072))[u] = 0u;
    __syncthreads();
    const XcdBarrier xbar = xcd_barrier_post((unsigned*)p.ws, (volatile __attribute__((address_space(3))) unsigned*)((__attribute__((address_space(3))) unsigned char*)lds + 131072 + 320) + 8);
#define GSYNC() xcd_barrier(xbar)
    if (threadIdx.x == 0) __hip_atomic_store((unsigned*)(p.ws + WS_XTAB) + blockIdx.x, xbar.x + 1u, __ATOMIC_RELAXED, __HIP_MEMORY_SCOPE_AGENT);
#define TEAM_SYNC(seam) do { if (gridDim.x == 256) { int b_ = blockIdx.x; asm volatile("" : "+s"(b_)); team_barrier((unsigned*)(p.ws + WS_TEAM) + ((layer * 2 + (seam)) * 64 + 8 * (b_ & 7) + ((b_ >> 3) & 7)) * 64, (unsigned*)p.ws, xbar.st + 2); } else GSYNC(); } while (0)
#define PHASE_VARS() int tid = threadIdx.x; asm volatile("" : "+v"(tid)); int bid = blockIdx.x, G = gridDim.x; asm volatile("" : "+s"(bid), "+s"(G)); \
    const int lane = tid & 63, wid = __builtin_amdgcn_readfirstlane(tid >> 6), gw = bid * 8 + wid, NGW = G * 8; (void)lane; (void)wid; (void)gw; (void)NGW; \
    __attribute__((address_space(1))) unsigned char* ws = (__attribute__((address_space(1))) unsigned char*)p.ws; asm volatile("" : "+s"(ws));     \
    __attribute__((address_space(3))) unsigned char* gl = (__attribute__((address_space(3))) unsigned char*)lds; (void)gl; \
    float* tscr = (float*)(lds + wid * 16384); (void)tscr;
#define WSP(T, off) ((T*)(ws + (off)))
#define SSQ(i) (WSP(float, WS_SSQ) + (size_t)(i) * M)
    {
        PHASE_VARS();
        {
#define LAYER_ 0
                const float* w_in = p.in[2] + (size_t)LAYER_ * DM * NIN; const float* w_out = p.in[7] + (size_t)LAYER_ * DM * DM;
                const float* w_uk = p.in[5] + (size_t)LAYER_ * 128 * 256; const float* w_uv = p.in[6] + (size_t)LAYER_ * 128 * 256;
                constexpr int I_IN = 16 * 112, I_OUT = 16 * 32, I_KV = 2 * 8;
                for (int it = gw; it < I_IN + I_OUT + 2 * I_KV; it += NGW) {
                    int r = it;
                    if (r < I_IN) { transpose_item<1, true>(w_in, DM, NIN, WSP(bf16_t, WS_WIN), 112, tscr, r, lane, p.in[1] + LAYER_ * DM); continue; } r -= I_IN;
                    if (r < I_OUT) { transpose_item<0, false>(w_out, DM, DM, WSP(bf16_t, WS_WOUT), 32, tscr, r, lane); continue; } r -= I_OUT;
                    if (r < I_KV) { transpose_item<0, false>(w_uk, 128, 256, WSP(bf16_t, WS_WKV), 8, tscr, r, lane); continue; } r -= I_KV;
                    transpose_item<0, false>(w_uv, 128, 256, WSP(bf16_t, WS_WKV) + 256 * 128, 8, tscr, r, lane);
                }
#undef LAYER_
        }
        if (M % (4 * NGW) == 0) { for (int m = gw; m < M; m += 4 * NGW) row_xb_ssq4(p.in[0], WSP(bf16_t, WS_XB), SSQ(0), m, NGW, lane); }
        else for (int m = gw; m < M; m += NGW) row_xb_ssq(p.in[0] + (size_t)m * DM, WSP(bf16_t, WS_XB) + (size_t)m * DM, SSQ(0) + m, lane);
    }
    GSYNC();
    if (threadIdx.x == 0 && gridDim.x == 256) {
        const unsigned* xt = (const unsigned*)(p.ws + WS_XTAB) + (blockIdx.x & 63); const unsigned x0 = xb_ld((unsigned*)xt);
        xbar.st[2] = (x0 != 0u && xb_ld((unsigned*)xt + 64) == x0 && xb_ld((unsigned*)xt + 128) == x0 && xb_ld((unsigned*)xt + 192) == x0) ? 1u : 0u; }
    if (p.ws == nullptr) grid.sync();
#pragma nounroll
    for (int layer = 0; layer < DEPTH; ++layer) {
        for (int rep_ = 0; rep_ < REP_GIN; ++rep_) {
        {
            PHASE_VARS();
            pg8::Gemm g{WSP(bf16_t, WS_XB), WSP(bf16_t, WINB(layer)), M, NP, DM}; pg8::StaticOrder So; So.init(M, NP, G, bid);
            pg8::EpiBf16<0> E{WSP(bf16_t, WS_PROJ), 64, M, C_KI >> 6, C_LQ >> 6, SSQ(2 * layer)};
            pg8::gemm_phase<pg8::EpiBf16<0>, pg8::StaticOrder, true, true>(gl, g, So, E);
            if (rep_ + 1 == REP_GIN) {
                const int maxu = (896 + G - 1) / G, nidle = G * maxu - 896, first = nidle ? G - nidle : 0;
                if (bid >= first) {
                    const float* w_up = p.in[9] + (size_t)layer * DM * DFF; const float* w_dn = p.in[10] + (size_t)layer * DFF * DM;
                    constexpr int I_UP = 16 * 128, I_DN = 64 * 32;
                    for (int it = (bid - first) * 8 + wid; it < I_UP + I_DN; it += (G - first) * 8) {
                        if (it < I_UP) transpose_item<0, true>(w_up, DM, DFF, WSP(bf16_t, WS_WUP), 128, tscr, it, lane, p.in[8] + layer * DM);
                        else transpose_item<0, false>(w_dn, DFF, DM, WSP(bf16_t, WS_WDN), 32, tscr, it - I_UP, lane);
                    }
                    if (layer + 1 < DEPTH) {
#define LAYER_ (layer + 1)
                        const float* w_in = p.in[2] + (size_t)LAYER_ * DM * NIN; const float* w_out = p.in[7] + (size_t)LAYER_ * DM * DM;
                        const float* w_uk = p.in[5] + (size_t)LAYER_ * 128 * 256; const float* w_uv = p.in[6] + (size_t)LAYER_ * 128 * 256;
                        constexpr int I_IN = 16 * 112, I_OUT = 16 * 32, I_KV = 2 * 8;
                        for (int it = (bid - first) * 8 + wid; it < I_IN + I_OUT + 2 * I_KV; it += (G - first) * 8) {
                            int r = it;
                            if (r < I_IN) { transpose_item<1, true>(w_in, DM, NIN, WSP(bf16_t, WINB(LAYER_)), 112, tscr, r, lane, p.in[1] + LAYER_ * DM); continue; } r -= I_IN;
                            if (r < I_OUT) { transpose_item<0, false>(w_out, DM, DM, WSP(bf16_t, WOUTB(LAYER_)), 32, tscr, r, lane); continue; } r -= I_OUT;
                            if (r < I_KV) { transpose_item<0, false>(w_uk, 128, 256, WSP(bf16_t, WKVB(LAYER_)), 8, tscr, r, lane); continue; } r -= I_KV;
                            transpose_item<0, false>(w_uv, 128, 256, WSP(bf16_t, WKVB(LAYER_)) + 256 * 128, 8, tscr, r, lane);
                        }
#undef LAYER_
                    }
                }
            }
        }
        if (rep_ + 1 < REP_GIN) GSYNC();
        }
        GSYNC();
        for (int rep_ = 0; rep_ < REP_MIXA; ++rep_) {
        {
            PHASE_VARS();
#if EN_DIL
            if (bid < 1024) { const int c8f = bid & 255, n4f = bid >> 8; idx_prefetch((LASP unsigned char*)lds + IDX_QST, WSP(bf16_t, WS_PROJ), n4f >> 1, (n4f & 1) ? (511 - c8f) : c8f, wid, lane); }
            for (int rp_ = 0; rp_ < RP_DIL; ++rp_) for (int it = bid; it < 256; it += G) {
                const int bh = (it & 7) + 8 * ((it >> 7) & 1), blk = (it >> 3) & 15;
                dil_item(lds, WSP(bf16_t, WS_PROJ), WSP(bf16_t, WS_MIXED), bh * 16 + blk, tid, lane, wid); }
#else
            zero_cols(WSP(bf16_t, WS_MIXED), 512, 512, bid * 512 + tid, G * 512);
#endif
#if EN_DSA
            for (int rp_ = 0; rp_ < RP_IDX; ++rp_) for (int it = bid; it < 1024; it += G) {
                const int n4 = it >> 8, c8 = it & 255; const int b = n4 >> 1, qt = (n4 & 1) ? (511 - c8) : c8;
                const int itn = it + G, n4n = itn >> 8, c8n = itn & 255; const int nb = n4n >> 1, nqt = (itn < 1024) ? ((n4n & 1) ? (511 - c8n) : c8n) : -1;
                idx_item(lds, WSP(bf16_t, WS_PROJ), (bf16_t*)((unsigned char*)p.out + (size_t)bid * SCR_PER_WG), WSP(unsigned char, WS_BM), b, qt, tid, lane, wid, nb, nqt, it == bid);
            }
            for (int rp_ = 0; rp_ < RP_DKV; ++rp_) for (int it = bid; it < 256; it += G) dsa_kv_item(lds, WSP(bf16_t, WS_PROJ), p.in[4] + layer * 128, WSP(bf16_t, WKVB(layer)), WSP(bf16_t, WS_DK), WSP(bf16_t, WS_DVT), it, lane, wid);
#else
            zero_cols(WSP(bf16_t, WS_MIXED), 256, 256, bid * 512 + tid, G * 512);
#endif
#if EN_RET
            for (int it = bid; it < 512; it += 2 * G) {
                const int it2 = (it + G < 512) ? it + G : it;
                const RkvLoads L0 = ret_kv_load(WSP(bf16_t, WS_PROJ), it, tid), L1 = ret_kv_load(WSP(bf16_t, WS_PROJ), it2, tid);
                ret_kv_images((LASP unsigned char*)lds, 0, L0, it, tid); ret_kv_images((LASP unsigned char*)lds, 32768, L1, it2, tid);
                __syncthreads();
                if (wid < 4) ret_kv_mma((LASP unsigned char*)lds, 0, WSP(float, WS_KVT), it, wid, lane);
                else if (it + G < 512) ret_kv_mma((LASP unsigned char*)lds, 32768, WSP(float, WS_KVT), it2, wid - 4, lane);
                __syncthreads();
            }
#else
            zero_cols(WSP(bf16_t, WS_MIXED), 0, 256, bid * 512 + tid, G * 512);
#endif
        }
        if (rep_ + 1 < REP_MIXA) GSYNC();
        }
        GSYNC();
        for (int rep_ = 0; rep_ < REP_MIXB; ++rep_) {
        {
            PHASE_VARS();
#if EN_DSA
            for (int rp_ = 0; rp_ < RP_ATT; ++rp_) for (int it = bid; it < 256; it += G) {
                const int bh = it & 7, pr = (it >> 3) & 31; const int b = bh >> 2, h = bh & 3;
                const int w4 = wid & 3, qs = pr * 128 + w4 * 32, ql = (63 - pr) * 128 + w4 * 32, ns = qs / 32 + 1, nl = ql / 32 + 1, x = (nl - ns) >> 1;
                LASP float* pbuf = (LASP float*)((LASP unsigned char*)lds) + w4 * (34 * 64);
                if (rp_) __syncthreads();
                if (wid < 4) { dsa_att_wave<0>(WSP(bf16_t, WS_PROJ), WSP(bf16_t, WS_DK), WSP(bf16_t, WS_DVT), (const unsigned*)WSP(unsigned char, WS_BM), WSP(bf16_t, WS_MIXED), b, h, qs, 0, ns, pbuf, lane);
                               dsa_att_wave<1>(WSP(bf16_t, WS_PROJ), WSP(bf16_t, WS_DK), WSP(bf16_t, WS_DVT), (const unsigned*)WSP(unsigned char, WS_BM), WSP(bf16_t, WS_MIXED), b, h, ql, 0, x, pbuf, lane); }
                else dsa_att_wave<2>(WSP(bf16_t, WS_PROJ), WSP(bf16_t, WS_DK), WSP(bf16_t, WS_DVT), (const unsigned*)WSP(unsigned char, WS_BM), WSP(bf16_t, WS_MIXED), b, h, ql, x, nl, pbuf, lane);
                __syncthreads();
            }
#endif
#if EN_RET
            { f32x4 cy0 = {0.f, 0.f, 0.f, 0.f}, cy1 = cy0; int cyn = -1, cybh = -1;
              for (int it = bid; it < 512; it += G) {
                const int bh = it & 7, c = (it >> 3) & 31;
                if (bh != cybh) cyn = -1;
                ret_out_item(lds, WSP(bf16_t, WS_PROJ), WSP(float, WS_KVT), p.in[3] + layer * 256, WSP(bf16_t, WS_MIXED), bh * 64 + ((it < 256) ? c : 63 - c), tid, lane, wid, cy0, cy1, cyn);
                cybh = bh; } }
#endif
        }
        if (rep_ + 1 < REP_MIXB) GSYNC();
        }
        GSYNC();
        {
            PHASE_VARS();
            pg8::Gemm g{WSP(bf16_t, WS_MIXED), WSP(bf16_t, WOUTB(layer)), M, DM, DM}; pg8::StaticOrder So; So.init(M, DM, G, bid);
            pg8::EpiResidB E{WSP(bf16_t, WS_XB), DM, SSQ(2 * layer + 1)};
            pg8::gemm_phase<pg8::EpiResidB, pg8::StaticOrder, false, true>(gl, g, So, E);
        }
        TEAM_SYNC(0);
        for (int rep_ = 0; rep_ < REP_GUP; ++rep_) {
        {
            PHASE_VARS();
            pg8::Gemm g{WSP(bf16_t, WS_XB), WSP(bf16_t, WS_WUP), M, DFF, DM}; pg8::StaticOrder So; So.init(M, DFF, G, bid);
            pg8::EpiBf16<2> E{WSP(bf16_t, WS_HID), DFF, 0, -1, 1 << 30, SSQ(2 * layer + 1)};
            pg8::gemm_phase<pg8::EpiBf16<2>, pg8::StaticOrder, true, true>(gl, g, So, E);
        }
        if (rep_ + 1 < REP_GUP) GSYNC();
        }
        TEAM_SYNC(1);
        {
            PHASE_VARS();
            pg8::Gemm g{WSP(bf16_t, WS_HID), WSP(bf16_t, WS_WDN), M, DM, DFF}; pg8::StaticOrder So; So.init(M, DM, G, bid);
            pg8::EpiResidB E{WSP(bf16_t, WS_XB), DM, SSQ(2 * layer + 2)};
            pg8::gemm_phase<pg8::EpiResidB, pg8::StaticOrder, false, true>(gl, g, So, E);
        }
        if (layer + 1 < DEPTH || gridDim.x != 256) GSYNC();
    }
    PHASE_VARS();
    if (G == 256) {
        const int pm = 8 * (bid & 7) + ((bid >> 3) & 7);
        team_barrier((unsigned*)(p.ws + 896 * 1024) + pm * 16, (unsigned*)p.ws, xbar.st + 2);
        const int base = pm * 256 + (bid >> 6) * 64;
        for (int m = base + wid; m < base + 64; m += 32) final_row4(WSP(bf16_t, WS_XB), p.in[11], SSQ(8), p.out, m, 8, lane);
    } else if (M % (4 * NGW) == 0) { for (int m = gw; m < M; m += 4 * NGW) final_row4(WSP(bf16_t, WS_XB), p.in[11], SSQ(8), p.out, m, NGW, lane); }
    else for (int m = gw; m < M; m += NGW) final_row(WSP(bf16_t, WS_XB) + (size_t)m * DM, p.in[11], SSQ(8) + m, p.out + (size_t)m * DM, lane);
}

extern "C" void kernel_launch(void* const* d_in, const int* in_sizes, int n_in, void* d_out, int out_size, void* d_ws, size_t ws_size, hipStream_t stream) {
    static int grid = 0;
    if (grid == 0) {
        if (n_in != 12 || in_sizes[0] != M * DM || out_size != M * DM || ws_size < WS_END) { fprintf(stderr, "kernel_launch: unexpected shapes (n_in %d, in0 %d, out %d, ws %zu); nothing launched\n", n_in, n_in > 0 ? in_sizes[0] : -1, out_size, ws_size); grid = -1; return; }
        int dev = 0, cus = 0, per_cu = 0;
        hipGetDevice(&dev); hipDeviceGetAttribute(&cus, hipDeviceAttributeMultiprocessorCount, dev);
        hipFuncSetAttribute((const void*)hymba_fwd, hipFuncAttributeMaxDynamicSharedMemorySize, LDS_BYTES);
        hipOccupancyMaxActiveBlocksPerMultiprocessor(&per_cu, (const void*)hymba_fwd, 512, LDS_BYTES);
        if (per_cu < 1) { fprintf(stderr, "kernel_launch: occupancy query reports %d blocks per CU\n", per_cu); per_cu = 1; }
        (void)hipGetLastError();
        grid = cus * per_cu; if (grid > 256) grid = 256;
    }
    if (grid < 0) return;
    if (hipMemsetAsync(d_ws, 0, 1u << 20, stream) != hipSuccess) { fprintf(stderr, "kernel_launch: hipMemsetAsync failed\n"); return; }
    Params p{};
    for (int i = 0; i < 12; ++i) p.in[i] = (const float*)d_in[i];
    p.out = (float*)d_out; p.ws = (unsigned char*)d_ws;
    void* args[] = {&p};
    hipError_t e = hipLaunchCooperativeKernel((const void*)hymba_fwd, dim3(grid), dim3(512), args, LDS_BYTES, stream);
    if (e != hipSuccess) fprintf(stderr, "cooperative launch failed: %s (grid %d)\n", hipGetErrorString(e), grid);
}
```
